# Optimizing an MI355X kernel written in HIP

```python
import math
import jax
import jax.numpy as jnp
from jax import lax
import numpy as np

D_MODEL = 2048
BATCH = 16
SEQ = 256
DEPTH = 2
DEC_BATCH = 8
DEC_SEQ = 1024
PAST_LEN = 512

GRID_W = 64
HEAD_DIM = 128
N_MIXERS = 4
GROUP_WIDTH = D_MODEL // N_MIXERS
RET_HEADS = GROUP_WIDTH // HEAD_DIM
GDN_HEADS = GROUP_WIDTH // HEAD_DIM
HG_HEADS = GROUP_WIDTH // HEAD_DIM
S5_CH = 16
S5_GROUPS = GROUP_WIDTH // S5_CH
S5_N = 64
GDN_CONV = 3
CHUNK = 64
HG_CHUNK = 16
ROPE_BASE = 10000.0
FFN_HIDDEN = -(-8 * D_MODEL // (3 * 256)) * 256
N_MOD = 6
EPS = 1e-6
LB_FLOOR = 1e-30
PROJ_WIDTH = 14 * GROUP_WIDTH + 4 * GDN_HEADS

kernel_name = 'hybrid_bidir_flow_trunk_step'


def _rmsnorm(x, w):
    xf = x.astype(jnp.float32)
    y = xf * lax.rsqrt(jnp.mean(xf * xf, axis=-1, keepdims=True) + EPS)
    return (y * w.astype(jnp.float32)).astype(x.dtype)


def _head_layernorm(x):
    mu = jnp.mean(x, axis=-1, keepdims=True)
    xc = x - mu
    return xc * lax.rsqrt(jnp.mean(xc * xc, axis=-1, keepdims=True) + EPS)


def _l2norm(x):
    return x * lax.rsqrt(jnp.sum(x * x, axis=-1, keepdims=True) + EPS)


def _heads(t, n_heads):
    b, l, _ = t.shape
    return t.reshape(b, l, n_heads, -1).transpose(0, 2, 1, 3)


def _merge(t):
    b, h, l, d = t.shape
    return t.transpose(0, 2, 1, 3).reshape(b, l, h * d)


def _chunks(t, size):
    return t.reshape(t.shape[:2] + (t.shape[2] // size, size) + t.shape[3:])


def _rev(t):
    return jnp.flip(t, axis=2)


def _axial_rope(l):
    n_rows = l // GRID_W
    t_row = jnp.repeat(jnp.arange(n_rows, dtype=jnp.float32), GRID_W)
    t_col = jnp.tile(jnp.arange(GRID_W, dtype=jnp.float32), n_rows)
    n_freq = HEAD_DIM // 4
    inv = ROPE_BASE ** (-jnp.arange(n_freq, dtype=jnp.float32) / n_freq)
    ang = jnp.concatenate([t_row[:, None] * inv, t_col[:, None] * inv], axis=-1)
    return jnp.cos(ang), jnp.sin(ang)


def _apply_rope(x, cos, sin):
    x1, x2 = jnp.split(x, 2, axis=-1)
    return jnp.concatenate([x1 * cos - x2 * sin, x1 * sin + x2 * cos], axis=-1)


def _dwconv(x, w):
    ch = x.shape[-1]
    pad = (GDN_CONV - 1) // 2
    return lax.conv_general_dilated(x, w[:, None, :], window_strides=(1,), padding=[(pad, pad)],
                                    dimension_numbers=('NWC', 'WIO', 'NWC'), feature_group_count=ch)


def _retention(q, k, v, log_gamma, s0):
    b, h, l, d = q.shape
    qc, kc, vc = _chunks(q, CHUNK), _chunks(k, CHUNK), _chunks(v, CHUNK)
    pos = jnp.arange(CHUNK, dtype=jnp.float32)
    rel = pos[:, None] - pos[None, :]
    intra = jnp.where(rel >= 0, jnp.exp(jnp.maximum(rel, 0.0) * log_gamma[:, None, None]), 0.0)
    q_dec = jnp.exp((pos + 1.0) * log_gamma[:, None])
    k_dec = jnp.exp((CHUNK - 1.0 - pos) * log_gamma[:, None])
    c_dec = jnp.exp(CHUNK * log_gamma)[None, :, None, None]
    scores = jnp.einsum('bhnid,bhnjd->bhnij', qc, kc) * intra[None, :, None]
    o_intra = jnp.einsum('bhnij,bhnje->bhnie', scores, vc)
    kv = jnp.einsum('bhnjd,hj,bhnje->bhnde', kc, k_dec, vc)

    def step(s, kv_n):
        return c_dec * s + kv_n, s

    s_fin, s_prev = lax.scan(step, s0, jnp.moveaxis(kv, 2, 0))
    o_inter = jnp.einsum('bhnid,hi,bhnde->bhnie', qc, q_dec, jnp.moveaxis(s_prev, 0, 2))
    return (o_intra + o_inter).reshape(b, h, l, d), s_fin


def _gated_delta(q, k, v, log_alpha, beta, s0):
    b, h, l, _ = q.shape
    qc, kc, vc = _chunks(q, CHUNK), _chunks(k, CHUNK), _chunks(v, CHUNK)
    g = jnp.cumsum(_chunks(log_alpha, CHUNK), axis=-1)
    bc = _chunks(beta, CHUNK)
    idx = jnp.arange(CHUNK)
    incl = idx[:, None] >= idx[None, :]
    strict = idx[:, None] > idx[None, :]
    decay = jnp.exp(jnp.where(incl, g[..., :, None] - g[..., None, :], -jnp.inf))
    kb = kc * bc[..., None]
    a_mat = jnp.where(strict, jnp.einsum('bhnid,bhnjd->bhnij', kb, kc) * decay, 0.0)
    eye = jnp.eye(CHUNK, dtype=jnp.float32)
    t_mat = lax.linalg.triangular_solve(a_mat + eye, jnp.broadcast_to(eye, a_mat.shape),
                                        left_side=True, lower=True, unit_diagonal=True)
    u = jnp.einsum('bhnij,bhnje->bhnie', t_mat, vc * bc[..., None])
    w = jnp.einsum('bhnij,bhnjd->bhnid', t_mat, kb * jnp.exp(g)[..., None])
    attn = jnp.einsum('bhnid,bhnjd->bhnij', qc, kc) * decay
    qg = qc * jnp.exp(g)[..., None]
    kt = kc * jnp.exp(g[..., -1:] - g)[..., None]
    cd = jnp.exp(g[..., -1])

    def step(s, xs):
        u_n, w_n, qg_n, at_n, kt_n, cd_n = xs
        v_new = u_n - jnp.einsum('bhcd,bhde->bhce', w_n, s)
        o = jnp.einsum('bhcd,bhde->bhce', qg_n, s) + jnp.einsum('bhcs,bhse->bhce', at_n, v_new)
        s = s * cd_n[..., None, None] + jnp.einsum('bhcd,bhce->bhde', kt_n, v_new)
        return s, o

    xs = (jnp.moveaxis(u, 2, 0), jnp.moveaxis(w, 2, 0), jnp.moveaxis(qg, 2, 0),
          jnp.moveaxis(attn, 2, 0), jnp.moveaxis(kt, 2, 0), jnp.moveaxis(cd, 2, 0))
    s_fin, o = lax.scan(step, s0, xs)
    return jnp.moveaxis(o, 0, 2).reshape(b, h, l, -1), s_fin


def _gla(q, k, v, log_f, s0):
    b, h, l, _ = q.shape
    qc, kc, vc, fc = (_chunks(q, HG_CHUNK), _chunks(k, HG_CHUNK), _chunks(v, HG_CHUNK), _chunks(log_f, HG_CHUNK))
    cum = jnp.cumsum(fc, axis=-2)
    idx = jnp.arange(HG_CHUNK)
    incl = (idx[:, None] >= idx[None, :])[:, :, None]
    dec = jnp.exp(jnp.where(incl, cum[..., :, None, :] - cum[..., None, :, :], -jnp.inf))
    attn = jnp.einsum('bhnid,bhnjd,bhnijd->bhnij', qc, kc, dec)
    o_intra = jnp.einsum('bhnij,bhnje->bhnie', attn, vc)
    q_in = qc * jnp.exp(cum)
    k_tail = kc * jnp.exp(cum[..., -1:, :] - cum)
    cd = jnp.exp(cum[..., -1, :])
    kv = jnp.einsum('bhnjd,bhnje->bhnde', k_tail, vc)

    def step(s, xs):
        kv_n, cd_n = xs
        return cd_n[..., None] * s + kv_n, s

    s_fin, s_prev = lax.scan(step, s0, (jnp.moveaxis(kv, 2, 0), jnp.moveaxis(cd, 2, 0)))
    o_inter = jnp.einsum('bhnid,bhnde->bhnie', q_in, jnp.moveaxis(s_prev, 0, 2))
    return (o_intra + o_inter).reshape(b, h, l, -1), s_fin


def _cplx_combine(e1, e2):
    a1r, a1i, b1r, b1i = e1
    a2r, a2i, b2r, b2i = e2
    return (a1r * a2r - a1i * a2i, a1r * a2i + a1i * a2r,
            a2r * b1r - a2i * b1i + b2r, a2r * b1i + a2i * b1r + b2i)


def _s5(u, a_re, a_im, log_step, b_re, b_im, c_re, c_im, x0_re, x0_im):
    dt = jnp.exp(log_step)[:, None]
    mag = jnp.exp(a_re * dt)
    ab_re = mag * jnp.cos(a_im * dt)
    ab_im = mag * jnp.sin(a_im * dt)
    den = a_re * a_re + a_im * a_im
    nr = ab_re - 1.0
    f_re = (nr * a_re + ab_im * a_im) / den
    f_im = (ab_im * a_re - nr * a_im) / den
    bb_re = f_re[..., None] * b_re - f_im[..., None] * b_im
    bb_im = f_re[..., None] * b_im + f_im[..., None] * b_re
    bu_re = jnp.einsum('blgc,gnc->blgn', u, bb_re)
    bu_im = jnp.einsum('blgc,gnc->blgn', u, bb_im)
    bu_re = bu_re.at[:, 0].add(ab_re * x0_re - ab_im * x0_im)
    bu_im = bu_im.at[:, 0].add(ab_re * x0_im + ab_im * x0_re)
    a_full_re = jnp.broadcast_to(ab_re, bu_re.shape)
    a_full_im = jnp.broadcast_to(ab_im, bu_im.shape)
    _, _, x_re, x_im = lax.associative_scan(_cplx_combine, (a_full_re, a_full_im, bu_re, bu_im), axis=1)
    y = jnp.einsum('blgn,gcn->blgc', x_re, c_re) - jnp.einsum('blgn,gcn->blgc', x_im, c_im)
    return y, x_re[:, -1], x_im[:, -1]


def _mixer(h, lp, lower_bound, s_ret, s_gdn, s_hg, s_s5_re, s_s5_im, rope):
    f32 = jnp.float32
    bsz, l, _ = h.shape
    w = GROUP_WIDTH
    widths = (w, w, w, w, w, w, w, w, 2 * GDN_HEADS, 2 * GDN_HEADS, w, 2 * w, w, w)
    offsets, acc = [], 0
    for wd in widths:
        acc += wd
        offsets.append(acc)
    proj = (h @ lp['in_proj']).astype(f32)
    (r_q, r_k, r_v, r_g, d_q, d_k, d_v, d_g, d_a, d_b,
     h_q, h_f, h_i, h_g, s_u) = jnp.split(proj, offsets, axis=-1)

    q = _heads(r_q, RET_HEADS)
    k = _heads(r_k, RET_HEADS)
    v = _heads(r_v, RET_HEADS)
    if rope is not None:
        q = _apply_rope(q, *rope)
        k = _apply_rope(k, *rope)
    k = k * HEAD_DIM ** -0.5
    log_gamma = jax.nn.log_sigmoid(lp['ret_decay_logit'].astype(f32))
    o_f, rs_f = _retention(q, k, v, log_gamma[0], s_ret[:, 0])
    o_b, rs_b = _retention(_rev(q), _rev(k), _rev(v), log_gamma[1], s_ret[:, 1])
    ret_out = _merge(_head_layernorm(o_f + _rev(o_b))) * jax.nn.silu(r_g)

    qkv = jax.nn.silu(_dwconv(jnp.concatenate([d_q, d_k, d_v], axis=-1), lp['gdn_conv'].astype(f32)))
    gq, gk, gv = jnp.split(qkv, 3, axis=-1)
    q = _l2norm(_heads(gq, GDN_HEADS)) * HEAD_DIM ** -0.5
    k = _l2norm(_heads(gk, GDN_HEADS))
    v = _heads(gv, GDN_HEADS)
    a = d_a.reshape(bsz, l, 2, GDN_HEADS)
    bt = d_b.reshape(bsz, l, 2, GDN_HEADS)
    log_alpha = (-jnp.exp(lp['gdn_a_log'].astype(f32))
                 * jax.nn.softplus(a + lp['gdn_dt_bias'].astype(f32))).transpose(2, 0, 3, 1)
    beta = jax.nn.sigmoid(bt).transpose(2, 0, 3, 1)
    o_f, gs_f = _gated_delta(q, k, v, log_alpha[0], beta[0], s_gdn[:, 0])
    o_b, gs_b = _gated_delta(_rev(q), _rev(k), _rev(v), _rev(log_alpha[1]), _rev(beta[1]), s_gdn[:, 1])
    gdn_out = _merge(_rmsnorm(o_f + _rev(o_b), lp['gdn_norm_w'])) * jax.nn.silu(d_g)

    q = _heads(jax.nn.silu(h_q), HG_HEADS) * HEAD_DIM ** -0.5
    v = _heads(h_i, HG_HEADS)
    fx = h_f.reshape(bsz, l, 2, w)
    log_f = jnp.logaddexp(jnp.log(jnp.maximum(lower_bound, LB_FLOOR)),
                          jnp.log1p(-lower_bound) + jax.nn.log_sigmoid(fx))
    key_in = (1.0 - lower_bound) * jax.nn.sigmoid(-fx)
    o_f, hs_f = _gla(q, _heads(key_in[:, :, 0], HG_HEADS), v, _heads(log_f[:, :, 0], HG_HEADS), s_hg[:, 0])
    o_b, hs_b = _gla(_rev(q), _rev(_heads(key_in[:, :, 1], HG_HEADS)), _rev(v),
                     _rev(_heads(log_f[:, :, 1], HG_HEADS)), s_hg[:, 1])
    hg_out = _merge(_rmsnorm(o_f + _rev(o_b), lp['hg_norm_w'])) * jax.nn.silu(h_g)

    u = s_u.reshape(bsz, l, S5_GROUPS, S5_CH)
    p = [lp[nm].astype(f32) for nm in ('s5_a_re', 's5_a_im', 's5_log_step', 's5_b_re', 's5_b_im', 's5_c_re', 's5_c_im')]
    y_f, xr_f, xi_f = _s5(u, p[0][0], p[1][0], p[2][0], p[3][0], p[4][0], p[5][0], p[6][0], s_s5_re[:, 0], s_s5_im[:, 0])
    y_b, xr_b, xi_b = _s5(jnp.flip(u, 1), p[0][1], p[1][1], p[2][1], p[3][1], p[4][1], p[5][1], p[6][1],
                          s_s5_re[:, 1], s_s5_im[:, 1])
    y = (y_f + jnp.flip(y_b, 1)).reshape(bsz, l, w) + lp['s5_d'].astype(f32) * s_u
    z = jax.nn.gelu(y)
    s5_out = z * jax.nn.sigmoid(z @ lp['s5_glu_w'].astype(f32) + lp['s5_glu_b'].astype(f32))

    mixed = jnp.concatenate([ret_out, gdn_out, hg_out, s5_out], axis=-1).astype(h.dtype) @ lp['out_proj']
    new_states = (jnp.stack([rs_f, rs_b], axis=1), jnp.stack([gs_f, gs_b], axis=1),
                  jnp.stack([hs_f, hs_b], axis=1), jnp.stack([xr_f, xr_b], axis=1),
                  jnp.stack([xi_f, xi_b], axis=1))
    return mixed, new_states


def _layer(x, mod, lp, lower_bound, states, rope):
    shift1, scale1, gate1, shift2, scale2, gate2 = jnp.split(mod[:, None, :], N_MOD, axis=-1)
    h = _rmsnorm(x, lp['norm1_w']) * (1.0 + scale1) + shift1
    mixed, new_states = _mixer(h, lp, lower_bound, states[0], states[1], states[2], states[3], states[4], rope)
    x = x + gate1 * mixed
    h = _rmsnorm(x, lp['norm2_w']) * (1.0 + scale2) + shift2
    ffn = (jax.nn.silu(h @ lp['ffn_w1']) * (h @ lp['ffn_w3'])) @ lp['ffn_w2']
    x = x + gate2 * ffn
    return x, new_states


def setup_inputs(seed: int = 0) -> dict:
    key = jax.random.key(seed)
    ks = iter(jax.random.split(key, 48))
    f32 = jnp.float32
    w = GROUP_WIDTH

    def nrm(shape, scale):
        return jax.random.normal(next(ks), shape, f32) * scale

    def unif(shape, lo, hi):
        return jax.random.uniform(next(ks), shape, f32, lo, hi)

    st_shape = (DEC_BATCH, DEPTH, 2, RET_HEADS, HEAD_DIM, HEAD_DIM)
    s5_st_shape = (DEC_BATCH, DEPTH, 2, S5_GROUPS, S5_N)
    gamma = 1.0 - 2.0 ** (-5.0 - jnp.arange(RET_HEADS, dtype=f32))
    dt = jnp.exp(unif((DEPTH, 2, GDN_HEADS), math.log(1e-3), math.log(0.1)))
    n_idx = jnp.arange(S5_N, dtype=f32)
    return {
        'x_prompt': nrm((BATCH, SEQ, D_MODEL), 1.0),
        'x_sample': nrm((DEC_BATCH, DEC_SEQ, D_MODEL), 1.0),
        'state_ret': nrm(st_shape, 0.5),
        'state_gdn': nrm(st_shape, 0.5),
        'state_hgrn': nrm(st_shape, 0.5),
        'state_s5_re': nrm(s5_st_shape, 0.1),
        'state_s5_im': nrm(s5_st_shape, 0.1),
        'c': nrm((DEC_BATCH, D_MODEL), 1.0),
        'c_ctx': nrm((D_MODEL,), 1.0),
        'norm1_w': 1.0 + nrm((DEPTH, D_MODEL), 0.01),
        'norm2_w': 1.0 + nrm((DEPTH, D_MODEL), 0.01),
        'final_norm_w': 1.0 + nrm((D_MODEL,), 0.01),
        'ada_w': nrm((DEPTH, D_MODEL, N_MOD * D_MODEL), 0.5 * D_MODEL ** -0.5),
        'ada_b': nrm((DEPTH, N_MOD * D_MODEL), 0.01),
        'in_proj': nrm((DEPTH, D_MODEL, PROJ_WIDTH), D_MODEL ** -0.5),
        'out_proj': nrm((DEPTH, D_MODEL, D_MODEL), D_MODEL ** -0.5),
        'ret_decay_logit': jnp.log(gamma / (1.0 - gamma)) + nrm((DEPTH, 2, RET_HEADS), 0.1),
        'gdn_conv': nrm((DEPTH, GDN_CONV, 3 * w), GDN_CONV ** -0.5),
        'gdn_a_log': jnp.log(unif((DEPTH, 2, GDN_HEADS), 1.0, 16.0)),
        'gdn_dt_bias': dt + jnp.log(-jnp.expm1(-dt)),
        'gdn_norm_w': 1.0 + nrm((DEPTH, HEAD_DIM), 0.01),
        'hg_lb_param': nrm((DEPTH, 2, w), 0.1),
        'hg_norm_w': 1.0 + nrm((DEPTH, HEAD_DIM), 0.01),
        's5_a_re': -0.5 + nrm((DEPTH, 2, S5_GROUPS, S5_N), 0.01),
        's5_a_im': jnp.pi * n_idx + nrm((DEPTH, 2, S5_GROUPS, S5_N), 0.01),
        's5_b_re': nrm((DEPTH, 2, S5_GROUPS, S5_N, S5_CH), (2 * S5_CH) ** -0.5),
        's5_b_im': nrm((DEPTH, 2, S5_GROUPS, S5_N, S5_CH), (2 * S5_CH) ** -0.5),
        's5_c_re': nrm((DEPTH, 2, S5_GROUPS, S5_CH, S5_N), S5_N ** -0.5),
        's5_c_im': nrm((DEPTH, 2, S5_GROUPS, S5_CH, S5_N), S5_N ** -0.5),
        's5_log_step': unif((DEPTH, 2, S5_GROUPS), math.log(1e-3), math.log(0.1)),
        's5_d': nrm((DEPTH, w), 1.0),
        's5_glu_w': nrm((DEPTH, w, w), w ** -0.5),
        's5_glu_b': nrm((DEPTH, w), 0.01),
        'ffn_w1': nrm((DEPTH, D_MODEL, FFN_HIDDEN), D_MODEL ** -0.5),
        'ffn_w3': nrm((DEPTH, D_MODEL, FFN_HIDDEN), D_MODEL ** -0.5),
        'ffn_w2': nrm((DEPTH, FFN_HIDDEN, D_MODEL), FFN_HIDDEN ** -0.5),
    }


def reference(x_prompt, x_sample, state_ret, state_gdn, state_hgrn, state_s5_re, state_s5_im, c, c_ctx,
              norm1_w, norm2_w, final_norm_w, ada_w, ada_b, in_proj, out_proj, ret_decay_logit,
              gdn_conv, gdn_a_log, gdn_dt_bias, gdn_norm_w, hg_lb_param, hg_norm_w,
              s5_a_re, s5_a_im, s5_b_re, s5_b_im, s5_c_re, s5_c_im, s5_log_step, s5_d,
              s5_glu_w, s5_glu_b, ffn_w1, ffn_w3, ffn_w2):
    f32 = jnp.float32
    lb_soft = jax.nn.softmax(hg_lb_param.astype(f32), axis=0)
    lower_bounds = jnp.cumsum(lb_soft, axis=0) - lb_soft[0]
    rope = _axial_rope(x_sample.shape[1])
    bp = x_prompt.shape[0]
    zero_mat = jnp.zeros((bp, 2, RET_HEADS, HEAD_DIM, HEAD_DIM), f32)
    zero_s5 = jnp.zeros((bp, 2, S5_GROUPS, S5_N), f32)
    ctx_init = (zero_mat, zero_mat, zero_mat, zero_s5, zero_s5)
    hp, hs = x_prompt, x_sample
    ctx_states = []
    for i in range(DEPTH):
        lp = {
            'norm1_w': norm1_w[i], 'norm2_w': norm2_w[i], 'in_proj': in_proj[i], 'out_proj': out_proj[i],
            'ret_decay_logit': ret_decay_logit[i], 'gdn_conv': gdn_conv[i], 'gdn_a_log': gdn_a_log[i],
            'gdn_dt_bias': gdn_dt_bias[i], 'gdn_norm_w': gdn_norm_w[i], 'hg_norm_w': hg_norm_w[i],
            's5_a_re': s5_a_re[i], 's5_a_im': s5_a_im[i], 's5_log_step': s5_log_step[i],
            's5_b_re': s5_b_re[i], 's5_b_im': s5_b_im[i], 's5_c_re': s5_c_re[i], 's5_c_im': s5_c_im[i],
            's5_d': s5_d[i], 's5_glu_w': s5_glu_w[i], 's5_glu_b': s5_glu_b[i],
            'ffn_w1': ffn_w1[i], 'ffn_w3': ffn_w3[i], 'ffn_w2': ffn_w2[i],
        }
        mod_ctx = jax.nn.silu(c_ctx)[None, :] @ ada_w[i] + ada_b[i]
        mod_lat = jax.nn.silu(c) @ ada_w[i] + ada_b[i]
        hp, st = _layer(hp, mod_ctx, lp, lower_bounds[i], ctx_init, None)
        ctx_states.append(st)
        lat_init = (state_ret[:, i].astype(f32), state_gdn[:, i].astype(f32), state_hgrn[:, i].astype(f32),
                    state_s5_re[:, i].astype(f32), state_s5_im[:, i].astype(f32))
        hs, _ = _layer(hs, mod_lat, lp, lower_bounds[i], lat_init, rope)
    y_prompt = _rmsnorm(hp, final_norm_w)
    y_sample = _rmsnorm(hs, final_norm_w)
    sdt = x_prompt.dtype
    new_ret = jnp.stack([s[0] for s in ctx_states], axis=1).astype(sdt)
    new_gdn = jnp.stack([s[1] for s in ctx_states], axis=1).astype(sdt)
    new_hgrn = jnp.stack([s[2] for s in ctx_states], axis=1).astype(sdt)
    new_s5_re = jnp.stack([s[3] for s in ctx_states], axis=1).astype(sdt)
    new_s5_im = jnp.stack([s[4] for s in ctx_states], axis=1).astype(sdt)
    return (y_prompt, y_sample, new_ret, new_gdn, new_hgrn, new_s5_re, new_s5_im)
```

```cpp
#include <hip/hip_runtime.h>
#include <hip/hip_cooperative_groups.h>
#include <cstdio>
namespace cg = cooperative_groups;
__device__ __forceinline__ int lane_id_() { return (int)__builtin_amdgcn_mbcnt_hi(~0u, __builtin_amdgcn_mbcnt_lo(~0u, 0u)); }
namespace pg8 {
#define PG8_LAS __attribute__((address_space(3)))
typedef unsigned short bf16_t;
typedef short bf16x8 __attribute__((ext_vector_type(8)));
typedef float f32x4 __attribute__((ext_vector_type(4)));
typedef unsigned u32x4 __attribute__((ext_vector_type(4)));
constexpr int BM = 256, BK = 64, HALF = 128, HTB = HALF * BK * 2  , STAGE_BYTES = 8 * HTB, NXCD = 8, WGM = 8;

__host__ __device__ __forceinline__ int lds_byte(int r, int c) { const int st = (r >> 4) * 2 + (c >> 5), rr = r & 15, cc = c & 31, ob = rr * 64 + cc * 2; return st * 1024 + (ob ^ (((ob >> 9) & 1) << 5)); }
__host__ __device__ __forceinline__ void stage_rc(int b, int& R, int& C) { const int st = b / 1024, sb = b % 1024, swz = sb ^ (((sb >> 9) & 1) << 5); R = (st >> 1) * 16 + swz / 64; C = (st & 1) * 32 + (swz % 64) / 2; }
__host__ __device__ __forceinline__ int perm32(int rho) { const int n = rho >> 4, i = rho & 15; return 8 * (i >> 2) + 4 * n + (i & 3); }

struct Unit { int pm, pn; };
struct Gemm { const bf16_t* A; const bf16_t* Bt; int M, N, K; };

struct StaticOrder {
    int nM, nN, nwg, G, c;
    __host__ __device__ void init(int M, int N, int G_, int c_) { nM = M / BM; nN = N / BM; nwg = nM * nN; G = G_; c = c_; }
    __host__ __device__ bool next(int i, Unit& u) const {
        const long L = (long)i * G + c; if (L >= nwg) return false;
        int wgid = (int)L; { const int q = nwg / NXCD, r = nwg % NXCD, xcd = wgid % NXCD, off = wgid / NXCD; wgid = (xcd < r ? xcd * (q + 1) : r * (q + 1) + (xcd - r) * q) + off; }
        const int nig = WGM * nN, gid = wgid / nig, fm = gid * WGM, gsz = (nM - fm) < WGM ? (nM - fm) : WGM;
        u.pm = fm + ((wgid % nig) % gsz); u.pn = (wgid % nig) / gsz; return true;
    }
    __device__ __forceinline__ void a_ready(const Unit&) const {}
    __device__ __forceinline__ void done(const Unit&) const {}
};
__device__ __forceinline__ unsigned cvt_pk_bf16(float lo, float hi) { unsigned r; asm volatile("v_cvt_pk_bf16_f32 %0, %1, %2" : "=v"(r) : "v"(lo), "v"(hi)); return r; }
typedef float f32x2 __attribute__((ext_vector_type(2)));
template <class Epi, class Sched, bool STAMP = false>
__device__ __forceinline__ void gemm_phase(PG8_LAS unsigned char* lds, const Gemm g, const Sched& S, const Epi& E, unsigned long long* stamps, const int wave_in) {
    const int wid = wave_in, lane = lane_id_(), tid = wid * 64 + lane, wr = wid >> 2, wc = wid & 3, fr = lane & 15, fq = lane >> 4;
    const int K = g.K, nt = K / BK;
    int ts_lo = 0, ts_hi = 0, nts = 0; const unsigned long long rt_entry = STAMP ? (unsigned long long)wall_clock64() : 0ull;
#define PG8_STAMP() do { if (STAMP && wid == 0 && nts < 64) { const unsigned long long _c = (unsigned long long)clock64(); \
        ts_lo = (lane == nts) ? (int)(unsigned)_c : ts_lo; ts_hi = (lane == nts) ? (int)(unsigned)(_c >> 32) : ts_hi; ++nts; } } while (0)
    PG8_STAMP();
    unsigned voffA[2], voffB[2];
#pragma unroll
    for (int i = 0; i < 2; ++i) { int R, C; stage_rc(tid * 16 + i * 8192, R, C); const int Rb = Epi::PERM ? ((R & ~31) + perm32(R & 31)) : R;
        voffA[i] = (unsigned)(R * K + C) * 2u; voffB[i] = (unsigned)(Rb * K + C) * 2u; }
    const size_t kstep = (size_t)(BK * 2);
    const size_t hstep = (size_t)HALF * K * 2;
    const size_t tstep = 2 * hstep;
    const unsigned ldsw = (unsigned)wid * 1024u;
    const int aoff = lds_byte(wr * 64 + fr, fq * 8), boff = lds_byte(wc * 32 + fr, fq * 8);
#define PG8_SA(b, h) (((b) * 2 + (h)) * HTB)
#define PG8_SB(b, h) ((4 + (b) * 2 + (h)) * HTB)
#define PG8_STAGE(bufoff, gbase, voff) do { _Pragma("unroll") for (int _i = 0; _i < 2; ++_i) \
        __builtin_amdgcn_global_load_lds((const unsigned*)((const char*)(gbase) + (voff)[_i]), (PG8_LAS unsigned*)(lds + (bufoff) + ldsw + _i * 8192), 16, 0, 0); } while (0)
#define PG8_LDA(dst, b, h) do { _Pragma("unroll") for (int m = 0; m < 4; ++m) _Pragma("unroll") for (int k = 0; k < 2; ++k) dst[m][k] = *(const PG8_LAS bf16x8*)(lds + PG8_SA(b, h) + aoff + m * 2048 + k * 1024); } while (0)
#define PG8_LDB(dst, b, h) do { _Pragma("unroll") for (int n = 0; n < 2; ++n) _Pragma("unroll") for (int k = 0; k < 2; ++k) dst[n][k] = *(const PG8_LAS bf16x8*)(lds + PG8_SB(b, h) + boff + n * 2048 + k * 1024); } while (0)
#define PG8_MMA(ai, bj, At, Bt) do { __builtin_amdgcn_s_setprio(1); _Pragma("unroll") for (int m = 0; m < 4; ++m) _Pragma("unroll") for (int n = 0; n < 2; ++n) _Pragma("unroll") for (int k = 0; k < 2; ++k) \
        acc[ai][bj][m][n] = __builtin_amdgcn_mfma_f32_16x16x32_bf16(Bt[n][k], At[m][k], acc[ai][bj][m][n], 0, 0, 0); __builtin_amdgcn_s_setprio(0); } while (0)
#define PG8_WAIT_V(n) asm volatile("s_waitcnt vmcnt(" #n ")" ::: "memory")
#define PG8_WAIT_L(n) asm volatile("s_waitcnt lgkmcnt(" #n ")" ::: "memory")
#define PG8_BAR __builtin_amdgcn_s_barrier()
#define PG8_SCHED __builtin_amdgcn_sched_barrier(0)
    Unit cur, nxt; int ui = 0;
    if (!S.next(0, cur)) return;
    f32x4 acc[2][2][4][2];
#pragma unroll
    for (int a = 0; a < 2; ++a)
#pragma unroll
        for (int b = 0; b < 2; ++b)
#pragma unroll
            for (int m = 0; m < 4; ++m)
#pragma unroll
                for (int n = 0; n < 2; ++n) acc[a][b][m][n] = (f32x4){0.f, 0.f, 0.f, 0.f};
    bf16x8 At[4][2], B0[2][2], B1[2][2];
    const char* cA = (const char*)g.A + (size_t)cur.pm * tstep; const char* cB = (const char*)g.Bt + (size_t)cur.pn * tstep;
    S.a_ready(cur);
    PG8_STAGE(PG8_SB(0, 0), cB, voffB); PG8_STAGE(PG8_SA(0, 0), cA, voffA); PG8_STAGE(PG8_SB(0, 1), cB + hstep, voffB); PG8_STAGE(PG8_SA(0, 1), cA + hstep, voffA);
    if (wr == 1) PG8_BAR;
    PG8_WAIT_V(4); PG8_BAR;
    PG8_STAGE(PG8_SB(1, 0), cB + kstep, voffB); PG8_STAGE(PG8_SA(1, 0), cA + kstep, voffA); PG8_STAGE(PG8_SB(1, 1), cB + hstep + kstep, voffB);
    PG8_WAIT_V(6); PG8_BAR;
    PG8_STAMP();
    for (;;) {
        const bool has_next = S.next(ui + 1, nxt);
        const char* nA = has_next ? (const char*)g.A + (size_t)nxt.pm * tstep : cA; const char* nB = has_next ? (const char*)g.Bt + (size_t)nxt.pn * tstep : cB;
        for (int t = 0; t < nt; t += 2) {
            const bool last = (t == nt - 2);
            const char* a1 = cA + (size_t)(t + 1) * kstep;
            const char* a2 = last ? nA : cA + (size_t)(t + 2) * kstep; const char* b2 = last ? nB : cB + (size_t)(t + 2) * kstep;
            const char* a3 = a2 + kstep; const char* b3 = b2 + kstep;
            if (last && has_next) S.a_ready(nxt);
            PG8_LDB(B0, 0, 0); PG8_SCHED; PG8_LDA(At, 0, 0); PG8_STAGE(PG8_SA(1, 1), a1 + hstep, voffA);
            PG8_WAIT_L(8); PG8_BAR; PG8_WAIT_L(0); PG8_MMA(0, 0, At, B0); PG8_BAR; PG8_SCHED;
            PG8_LDB(B1, 0, 1); PG8_STAGE(PG8_SB(0, 0), b2, voffB);
            PG8_BAR; PG8_WAIT_L(0); PG8_MMA(0, 1, At, B1); PG8_BAR;
            PG8_LDA(At, 0, 1); PG8_STAGE(PG8_SA(0, 0), a2, voffA);
            PG8_BAR; PG8_WAIT_L(0); PG8_MMA(1, 0, At, B0); PG8_BAR; PG8_SCHED;
            PG8_STAGE(PG8_SB(0, 1), b2 + hstep, voffB);
            PG8_WAIT_V(6); PG8_BAR; PG8_MMA(1, 1, At, B1); PG8_BAR;
            PG8_LDB(B0, 1, 0); PG8_SCHED; PG8_LDA(At, 1, 0); PG8_STAGE(PG8_SA(0, 1), a2 + hstep, voffA);
            PG8_WAIT_L(8); PG8_BAR; PG8_WAIT_L(0); PG8_MMA(0, 0, At, B0); PG8_BAR; PG8_SCHED;
            PG8_LDB(B1, 1, 1); PG8_STAGE(PG8_SB(1, 0), b3, voffB);
            PG8_BAR; PG8_WAIT_L(0); PG8_MMA(0, 1, At, B1); PG8_BAR;
            PG8_LDA(At, 1, 1); PG8_STAGE(PG8_SA(1, 0), a3, voffA);
            PG8_BAR; PG8_WAIT_L(0); PG8_MMA(1, 0, At, B0); PG8_BAR; PG8_SCHED;
            PG8_STAGE(PG8_SB(1, 1), b3 + hstep, voffB);
            PG8_WAIT_V(6); PG8_BAR; PG8_MMA(1, 1, At, B1); PG8_BAR;
        }
        PG8_STAMP();
        if constexpr (!Epi::AFTER_DRAIN) { E(acc, cur, wr, wc, fr, fq); S.done(cur); }
        PG8_STAMP();
        if (!has_next) break;
#pragma unroll
        for (int a = 0; a < 2; ++a)
#pragma unroll
            for (int b = 0; b < 2; ++b)
#pragma unroll
                for (int m = 0; m < 4; ++m)
#pragma unroll
                    for (int n = 0; n < 2; ++n) acc[a][b][m][n] = (f32x4){0.f, 0.f, 0.f, 0.f};
        cur = nxt; cA = nA; cB = nB; ++ui;
    }
    PG8_WAIT_V(0);
    if (wr == 0) PG8_BAR;
    PG8_BAR;
    if constexpr (Epi::AFTER_DRAIN) { E.fused(acc, cur, wr, wc, fr, fq, lds, wid, lane); S.done(cur); }
    PG8_STAMP();
    if (STAMP && wid == 0) { stamps[lane] = lane < nts ? (((unsigned long long)(unsigned)ts_hi << 32) | (unsigned)ts_lo) : 0ull;
        if (lane == 62) stamps[62] = rt_entry; if (lane == 63) stamps[63] = (unsigned long long)wall_clock64(); }
#undef PG8_STAMP
#undef PG8_SA
#undef PG8_SB
#undef PG8_STAGE
#undef PG8_LDA
#undef PG8_LDB
#undef PG8_MMA
#undef PG8_WAIT_V
#undef PG8_WAIT_L
#undef PG8_BAR
#undef PG8_SCHED
}
}

#define LAS __attribute__((address_space(3)))
#define DEV __device__ __forceinline__
typedef unsigned short bf16_t;
typedef float v4f __attribute__((ext_vector_type(4)));
typedef float v2f __attribute__((ext_vector_type(2)));
typedef unsigned v4u __attribute__((ext_vector_type(4)));
typedef unsigned v2u __attribute__((ext_vector_type(2)));

constexpr int T_TOK = 12288, NTP = 4096, DM = 2048, PW = 7168, FFH = 5632, NMOD = 12288;
constexpr int NTHREADS = 512, NWAVES = 8;
constexpr int LDS_BYTES = 131072;
constexpr float EPSN = 1e-6f;
constexpr float HD_SCALE = 0.08838834764831845f;

constexpr size_t WS_CTL = 0;
constexpr size_t WS_MOD = 4096;
constexpr size_t WS_LB = WS_MOD + (size_t)2 * 9 * NMOD * 4;
constexpr size_t WS_S5A = WS_LB + 2 * 2 * 512 * 4;
constexpr size_t WS_S5B = WS_S5A + 2 * 8192 * 4;
constexpr size_t WS_ROPE = WS_S5B + 2 * 131072 * 4;
constexpr size_t WS_AB = WS_ROPE + 2 * 65536 * 4;
constexpr size_t WS_WABT = WS_AB + (size_t)T_TOK * 16 * 4;
constexpr size_t WS_WIN = WS_WABT + (size_t)2 * 16 * DM * 4;
constexpr size_t WS_WOUT = WS_WIN + (size_t)2 * PW * DM * 2;
constexpr size_t WS_W13 = WS_WOUT + (size_t)2 * DM * DM * 2;
constexpr size_t WS_W2 = WS_W13 + (size_t)2 * 2 * FFH * DM * 2;
constexpr size_t WS_WGLU = WS_W2 + (size_t)2 * DM * FFH * 2;
constexpr size_t WS_HB = WS_WGLU + (size_t)2 * 512 * 512 * 2;
constexpr size_t WS_Z = WS_HB + (size_t)T_TOK * DM * 2;
constexpr size_t WS_XRES = WS_Z + (size_t)T_TOK * 512 * 2;
constexpr size_t WS_PROJ = WS_XRES + (size_t)T_TOK * DM * 4;
constexpr size_t WS_OBUF = WS_PROJ + (size_t)T_TOK * PW * 2;
constexpr size_t WS_END = WS_OBUF + (size_t)2 * T_TOK * DM * 4;

struct Params { const float* in[36]; float* out; unsigned char* ws; int ph_lo, ph_hi; };
enum { I_XP = 0, I_XS, I_SRET, I_SGDN, I_SHG, I_S5RE, I_S5IM, I_C, I_CCTX, I_N1W, I_N2W, I_FNW, I_ADAW, I_ADAB, I_INP, I_OUTP, I_RETL, I_GCONV, I_GALOG, I_GDTB,
       I_GNW, I_HLB, I_HNW, I_SARE, I_SAIM, I_SBRE, I_SBIM, I_SCRE, I_SCIM, I_SLOG, I_S5D, I_GLUW, I_GLUB, I_W1, I_W3, I_W2 };
constexpr size_t O_Y = 0;
constexpr size_t O_RET = (size_t)T_TOK * DM;
constexpr size_t O_GDN = O_RET + 4194304;
constexpr size_t O_HG = O_GDN + 4194304;
constexpr size_t O_S5RE = O_HG + 4194304;
constexpr size_t O_S5IM = O_S5RE + 131072;

DEV float bf2f(bf16_t v) { return __uint_as_float(((unsigned)v) << 16); }
DEV unsigned pk2(float lo, float hi) { unsigned r; asm volatile("v_cvt_pk_bf16_f32 %0, %1, %2" : "=v"(r) : "v"(lo), "v"(hi)); return r; }
DEV float lo_bf(unsigned w) { return __uint_as_float(w << 16); }
DEV float hi_bf(unsigned w) { return __uint_as_float(w & 0xffff0000u); }
DEV void unpack8(v4u w, float (&f)[8]) { f[0] = lo_bf(w.x); f[1] = hi_bf(w.x); f[2] = lo_bf(w.y); f[3] = hi_bf(w.y); f[4] = lo_bf(w.z); f[5] = hi_bf(w.z); f[6] = lo_bf(w.w); f[7] = hi_bf(w.w); }
DEV v4u pack8(const float (&f)[8]) { v4u w; w.x = pk2(f[0], f[1]); w.y = pk2(f[2], f[3]); w.z = pk2(f[4], f[5]); w.w = pk2(f[6], f[7]); return w; }
DEV float sigmoidf_(float x) { return __builtin_amdgcn_rcpf(1.0f + __expf(-x)); }
DEV float siluf_(float x) { return x * sigmoidf_(x); }
template <int CTRL> DEV float dppf(float v) { return __builtin_bit_cast(float, __builtin_amdgcn_update_dpp(0, __builtin_bit_cast(int, v), CTRL, 0xf, 0xf, false)); }
DEV float row16_sum(float v) {
    v += dppf<0xB1>(v); v += dppf<0x4E>(v); v += dppf<0x141>(v); v += dppf<0x140>(v); return v;
}
DEV float wave_sum(float v) { v = row16_sum(v); v += __shfl_xor(v, 16); v += __shfl_xor(v, 32); return v; }
#define LDS_WAIT() asm volatile("s_waitcnt lgkmcnt(0)" ::: "memory")
DEV int seq_len(int seq) { return seq < 16 ? 256 : 1024; }
DEV int seq_tok0(int seq) { return seq < 16 ? seq * 256 : NTP + (seq - 16) * 1024; }
DEV int mod_row_of(int row) { return row < NTP ? 0 : 1 + ((row - NTP) >> 10); }

struct EpiProjBf16 {
    static constexpr bool PERM = true, AFTER_DRAIN = false;
    bf16_t* O; int ldc;
    DEV void operator()(const pg8::f32x4 (&acc)[2][2][4][2], const pg8::Unit& u, int wr, int wc, int fr, int fq) const {
        const int row0 = u.pm * 256 + wr * 64 + fr, col0 = u.pn * 256 + wc * 32 + 8 * fq;
#pragma unroll
        for (int ai = 0; ai < 2; ++ai)
#pragma unroll
            for (int m = 0; m < 4; ++m) { bf16_t* rowp = O + (size_t)(row0 + ai * 128 + m * 16) * ldc + col0;
#pragma unroll
                for (int bj = 0; bj < 2; ++bj) { const pg8::f32x4 v0 = acc[ai][bj][m][0], v1 = acc[ai][bj][m][1];
                    v4u w; w.x = pk2(v0[0], v0[1]); w.y = pk2(v0[2], v0[3]); w.z = pk2(v1[0], v1[1]); w.w = pk2(v1[2], v1[3]);
                    *(v4u*)(rowp + bj * 128) = w; } }
    }
};
struct EpiGated {
    static constexpr bool PERM = true, AFTER_DRAIN = false;
    bf16_t* O;
    DEV void operator()(const pg8::f32x4 (&acc)[2][2][4][2], const pg8::Unit& u, int wr, int wc, int fr, int fq) const {
        const int row0 = u.pm * 256 + wr * 64 + fr, col0 = u.pn * 128 + wc * 32 + 8 * fq;
#pragma unroll
        for (int ai = 0; ai < 2; ++ai)
#pragma unroll
            for (int m = 0; m < 4; ++m) { bf16_t* rowp = O + (size_t)(row0 + ai * 128 + m * 16) * FFH + col0;
                float f[8];
#pragma unroll
                for (int n = 0; n < 2; ++n)
#pragma unroll
                    for (int j = 0; j < 4; ++j) f[n * 4 + j] = siluf_(acc[ai][0][m][n][j]) * acc[ai][1][m][n][j];
                *(v4u*)rowp = pack8(f); }
    }
};
struct EpiResid {
    static constexpr bool PERM = false, AFTER_DRAIN = false;
    const float* bA; const float* bB; int rowoffB; float* out; const float* gate;
    DEV void operator()(const pg8::f32x4 (&acc)[2][2][4][2], const pg8::Unit& u, int wr, int wc, int fr, int fq) const {
        const int row0 = u.pm * 256 + wr * 64 + fr, col0 = u.pn * 256 + wc * 32 + 4 * fq;
        const int mr = u.pm < 16 ? 0 : 1 + ((u.pm - 16) >> 2);
        const float* g = gate + (size_t)mr * NMOD + col0;
        pg8::f32x4 gv[2][2];
#pragma unroll
        for (int bj = 0; bj < 2; ++bj)
#pragma unroll
            for (int n = 0; n < 2; ++n) gv[bj][n] = *(const pg8::f32x4*)(g + bj * 128 + n * 16);
#pragma unroll
        for (int ai = 0; ai < 2; ++ai)
#pragma unroll
            for (int m = 0; m < 4; ++m) { const int r = row0 + ai * 128 + m * 16;
                const float* bp = (r < NTP ? bA + (size_t)r * DM : bB + (size_t)(r - rowoffB) * DM) + col0; float* op = out + (size_t)r * DM + col0;
#pragma unroll
                for (int bj = 0; bj < 2; ++bj)
#pragma unroll
                    for (int n = 0; n < 2; ++n) { const pg8::f32x4 b = *(const pg8::f32x4*)(bp + bj * 128 + n * 16);
                        *(pg8::f32x4*)(op + bj * 128 + n * 16) = b + gv[bj][n] * acc[ai][bj][m][n]; } }
    }
};
struct EpiGlu {
    static constexpr bool PERM = true, AFTER_DRAIN = false;
    const bf16_t* Z; bf16_t* MIX; const float* bias;
    DEV void operator()(const pg8::f32x4 (&acc)[2][2][4][2], const pg8::Unit& u, int wr, int wc, int fr, int fq) const {
        const int row0 = u.pm * 256 + wr * 64 + fr, col0 = u.pn * 256 + wc * 32 + 8 * fq;
#pragma unroll
        for (int bj = 0; bj < 2; ++bj) { const int c = col0 + bj * 128;
            const v4f b0 = *(const v4f*)(bias + c), b1 = *(const v4f*)(bias + c + 4);
#pragma unroll
            for (int ai = 0; ai < 2; ++ai)
#pragma unroll
                for (int m = 0; m < 4; ++m) { const int r = row0 + ai * 128 + m * 16;
                    float z[8]; unpack8(*(const v4u*)(Z + (size_t)r * 512 + c), z);
                    float f[8];
#pragma unroll
                    for (int j = 0; j < 4; ++j) { f[j] = z[j] * sigmoidf_(acc[ai][bj][m][0][j] + b0[j]); f[4 + j] = z[4 + j] * sigmoidf_(acc[ai][bj][m][1][j] + b1[j]); }
                    *(v4u*)(MIX + (size_t)r * DM + 1536 + c) = pack8(f); } }
    }
};

DEV void tr_item(const float* W, int ldw, int srcc0, bf16_t* WT, int Kd, int dstr0, int k0, LAS float* scr, int lane) {
#pragma unroll 8
    for (int i = 0; i < 32; ++i) { const int kk = 2 * i + (lane >> 5); scr[kk * 33 + (lane & 31)] = W[(size_t)(k0 + kk) * ldw + srcc0 + (lane & 31)]; }
    LDS_WAIT();
    const int c = lane & 7;
#pragma unroll
    for (int j = 0; j < 4; ++j) { const int n = (lane >> 3) + 8 * j; const LAS float* s = scr + (8 * c) * 33 + n;
        v4u o; o.x = pk2(s[0 * 33], s[1 * 33]); o.y = pk2(s[2 * 33], s[3 * 33]); o.z = pk2(s[4 * 33], s[5 * 33]); o.w = pk2(s[6 * 33], s[7 * 33]);
        *(v4u*)(WT + (size_t)(dstr0 + n) * Kd + k0 + 8 * c) = o; }
    LDS_WAIT();
}

DEV void phase0(const Params& p, LAS unsigned char* lds, const int wave) {
    const int lane = lane_id_(), tid = wave * 64 + lane;
    const int gtid = blockIdx.x * NTHREADS + tid, NT = gridDim.x * NTHREADS;
    unsigned char* ws = p.ws;
    {
        float* LB = (float*)(ws + WS_LB); const float* lp = p.in[I_HLB];
        for (int i = gtid; i < 1024; i += NT) { const float a = lp[i], b = lp[1024 + i], m = fmaxf(a, b); const float ea = expf(a - m), eb = expf(b - m);
            LB[i] = 0.f; LB[1024 + i] = eb / (ea + eb); }
    }
    {
        float* AR = (float*)(ws + WS_S5A); float* AI = AR + 8192; float* BR = (float*)(ws + WS_S5B); float* BI = BR + 131072;
        for (int i = gtid; i < 8192; i += NT) {
            const float are = p.in[I_SARE][i], aim = p.in[I_SAIM][i], dt = expf(p.in[I_SLOG][i >> 6]);
            const float mag = expf(are * dt); float sn, cs; sincosf(aim * dt, &sn, &cs);
            const float abr = mag * cs, abi = mag * sn; AR[i] = abr; AI[i] = abi;
            const float den = are * are + aim * aim, nr = abr - 1.0f;
            const float fre = (nr * are + abi * aim) / den, fim = (abi * are - nr * aim) / den;
            for (int c = 0; c < 16; ++c) { const float br = p.in[I_SBRE][i * 16 + c], bi = p.in[I_SBIM][i * 16 + c];
                BR[i * 16 + c] = fre * br - fim * bi; BI[i * 16 + c] = fre * bi + fim * br; }
        }
    }
    {
        float* RC = (float*)(ws + WS_ROPE); float* RS = RC + 65536;
        for (int i = gtid; i < 65536; i += NT) { const int pos = i >> 6, j = i & 63, fi = j & 31;
            const float inv = expf(-(float)fi * (9.210340371976184f / 32.0f)); const float t = (float)(j < 32 ? (pos >> 6) : (pos & 63));
            float sn, cs; sincosf(t * inv, &sn, &cs); RC[i] = cs; RS[i] = sn; }
    }
    {
        float* WT = (float*)(ws + WS_WABT);
        for (int i = gtid; i < 2 * 16 * DM; i += NT) { const int l = i >> 15, q = (i >> 11) & 15, c = i & 2047; WT[i] = p.in[I_INP][(size_t)l * DM * 7184 + (size_t)c * 7184 + 4096 + q]; }
    }
    if ((int)blockIdx.x < 192) {
        LAS float* sc = (LAS float*)lds;
        LAS float* red = (LAS float*)(lds + 73728);
        for (int i = tid; i < 9 * 2048; i += NTHREADS) { const int r = i >> 11, k = i & 2047; const float v = (r == 0) ? p.in[I_CCTX][k] : p.in[I_C][(r - 1) * 2048 + k]; sc[i] = siluf_(v); }
        __syncthreads();
        for (int item = blockIdx.x; item < 192; item += gridDim.x) {
            const int l = item / 96, j0 = (item % 96) * 128;
            const float* W = p.in[I_ADAW] + (size_t)l * DM * NMOD + j0 + lane * 2;
            v2f acc[9];
#pragma unroll
            for (int r = 0; r < 9; ++r) acc[r] = (v2f){0.f, 0.f};
            for (int k = wave * 256; k < wave * 256 + 256; k += 4) {
                v2f w[4];
#pragma unroll
                for (int q = 0; q < 4; ++q) w[q] = *(const v2f*)(W + (size_t)(k + q) * NMOD);
#pragma unroll
                for (int r = 0; r < 9; ++r) { const v4f s = *(const LAS v4f*)(sc + r * 2048 + k);
                    acc[r] += w[0] * s.x; acc[r] += w[1] * s.y; acc[r] += w[2] * s.z; acc[r] += w[3] * s.w; }
            }
#pragma unroll
            for (int r = 0; r < 9; ++r) { red[(wave * 18 + r * 2) * 64 + lane] = acc[r].x; red[(wave * 18 + r * 2 + 1) * 64 + lane] = acc[r].y; }
            __syncthreads();
            for (int o = tid; o < 18 * 64; o += NTHREADS) { const int rr = o >> 6, ln = o & 63; float s = 0.f;
#pragma unroll
                for (int w = 0; w < 8; ++w) s += red[(w * 18 + rr) * 64 + ln];
                const int r = rr >> 1, j = j0 + ln * 2 + (rr & 1);
                ((float*)(ws + WS_MOD))[(size_t)(l * 9 + r) * NMOD + j] = s + p.in[I_ADAB][l * NMOD + j]; }
            __syncthreads();
        }
    }
    __syncthreads();
    {
        LAS float* scr = (LAS float*)(lds + wave * 8448);
        const int gw = blockIdx.x * NWAVES + wave, NGW = gridDim.x * NWAVES;
        constexpr int I_IN = 32 * 224, I_OUT = 32 * 64, I_13 = 32 * 352, I_2 = 88 * 64, I_G = 8 * 16, I_L = I_IN + I_OUT + I_13 + I_2 + I_G;
        for (int it = gw; it < 2 * I_L; it += NGW) {
            const int l = it / I_L; int r = it % I_L;
            if (r < I_IN) { const int kb = r / 224, nb = r % 224, n0 = nb * 32;
                tr_item(p.in[I_INP] + (size_t)l * DM * 7184, 7184, n0 < 4096 ? n0 : n0 + 16, (bf16_t*)(ws + WS_WIN) + (size_t)l * PW * DM, DM, n0, kb * 64, scr, lane); continue; }
            r -= I_IN;
            if (r < I_OUT) { const int kb = r / 64, nb = r % 64;
                tr_item(p.in[I_OUTP] + (size_t)l * DM * DM, DM, nb * 32, (bf16_t*)(ws + WS_WOUT) + (size_t)l * DM * DM, DM, nb * 32, kb * 64, scr, lane); continue; }
            r -= I_OUT;
            if (r < I_13) { const int kb = r / 352, nb = r % 352, n0 = nb * 32, tile = n0 >> 8, within = n0 & 255;
                const float* src = (within < 128 ? p.in[I_W1] : p.in[I_W3]) + (size_t)l * DM * FFH;
                tr_item(src, FFH, tile * 128 + (within & 127), (bf16_t*)(ws + WS_W13) + (size_t)l * 2 * FFH * DM, DM, n0, kb * 64, scr, lane); continue; }
            r -= I_13;
            if (r < I_2) { const int kb = r / 64, nb = r % 64;
                tr_item(p.in[I_W2] + (size_t)l * FFH * DM, DM, nb * 32, (bf16_t*)(ws + WS_W2) + (size_t)l * DM * FFH, FFH, nb * 32, kb * 64, scr, lane); continue; }
            r -= I_2;
            { const int kb = r / 16, nb = r % 16;
                tr_item(p.in[I_GLUW] + (size_t)l * 512 * 512, 512, nb * 32, (bf16_t*)(ws + WS_WGLU) + (size_t)l * 512 * 512, 512, nb * 32, kb * 64, scr, lane); }
        }
    }
}

template <int WHICH> DEV void norm_phase(const Params& p, int l, const int wave) {
    const int lane = lane_id_();
    const int gw = blockIdx.x * NWAVES + wave, NGW = gridDim.x * NWAVES;
    unsigned char* ws = p.ws;
    const float* XR = (const float*)(ws + WS_XRES);
    for (int row = gw; row < T_TOK; row += NGW) {
        const float* x;
        if (WHICH == 0 && l == 0) x = row < NTP ? p.in[I_XP] + (size_t)row * DM : p.in[I_XS] + (size_t)(row - NTP) * DM; else x = XR + (size_t)row * DM;
        v4f v[8]; float ss = 0.f;
#pragma unroll
        for (int j = 0; j < 8; ++j) { v[j] = *(const v4f*)(x + lane * 4 + 256 * j); ss += (v[j].x * v[j].x + v[j].y * v[j].y) + (v[j].z * v[j].z + v[j].w * v[j].w); }
        const float rstd = rsqrtf(wave_sum(ss) * (1.0f / DM) + EPSN);
        if (WHICH == 2) {
            const float* w = p.in[I_FNW]; float* o = p.out + O_Y + (size_t)row * DM;
#pragma unroll
            for (int j = 0; j < 8; ++j) { const v4f wv = *(const v4f*)(w + lane * 4 + 256 * j); *(v4f*)(o + lane * 4 + 256 * j) = v[j] * rstd * wv; }
        } else {
            const float* mod = (const float*)(ws + WS_MOD) + (size_t)(l * 9 + mod_row_of(row)) * NMOD;
            const float* shift = mod + (WHICH ? 3 : 0) * DM; const float* scale = mod + (WHICH ? 4 : 1) * DM;
            const float* w = p.in[WHICH ? I_N2W : I_N1W] + l * DM;
            bf16_t* o = (bf16_t*)(ws + WS_HB) + (size_t)row * DM;
#pragma unroll
            for (int j = 0; j < 8; ++j) { const int c = lane * 4 + 256 * j;
                const v4f wv = *(const v4f*)(w + c), sh = *(const v4f*)(shift + c), scl = *(const v4f*)(scale + c);
                const v4f h = v[j] * rstd * wv * (1.0f + scl) + sh; v[j] = h;
                v2u pk; pk.x = pk2(h.x, h.y); pk.y = pk2(h.z, h.w); *(v2u*)(o + c) = pk; }
            if (WHICH == 0) {
                const float* wt = (const float*)(ws + WS_WABT) + (size_t)l * 16 * DM + lane * 4; float mine = 0.f;
#pragma unroll 2
                for (int q = 0; q < 16; ++q) { float s = 0.f;
#pragma unroll
                    for (int j = 0; j < 8; ++j) { const v4f wq = *(const v4f*)(wt + q * DM + 256 * j); s += (v[j].x * wq.x + v[j].y * wq.y) + (v[j].z * wq.z + v[j].w * wq.w); }
                    s = wave_sum(s); mine = (lane == q) ? s : mine; }
                if (lane < 16) ((float*)(ws + WS_AB))[(size_t)row * 16 + lane] = mine;
            }
        }
    }
}

constexpr int NB = 32;
template <int MT> DEV void chain_task(const Params& p, int l, int seq, int hh, int dir, LAS float* lds, const int wave) {
    const int lane = lane_id_(), tid = wave * 64 + lane, dg = lane & 15, eg = lane >> 4;
    const int L = seq_len(seq), tok0 = seq_tok0(seq); const bool samp = seq >= 16;
    const int e0 = wave * 16 + eg * 4, d0 = dg * 8;
    unsigned char* ws = p.ws;
    const bf16_t* PROJ = (const bf16_t*)(ws + WS_PROJ);
    float* OB = (float*)(ws + WS_OBUF) + (size_t)dir * T_TOK * DM + MT * 512 + hh * 128 + e0;
    LAS float* qs = lds; LAS float* ks = lds + NB * 128; LAS float* vs = lds + 2 * NB * 128; LAS float* fs = lds + 3 * NB * 128; LAS float* scl = lds + 4 * NB * 128;
    v4f S[8];
    if (samp) { const float* st = p.in[MT == 0 ? I_SRET : (MT == 1 ? I_SGDN : I_SHG)] + ((((size_t)(seq - 16) * 2 + l) * 2 + dir) * 4 + hh) * 16384;
#pragma unroll
        for (int i = 0; i < 8; ++i) S[i] = *(const v4f*)(st + (d0 + i) * 128 + e0);
    } else {
#pragma unroll
        for (int i = 0; i < 8; ++i) S[i] = (v4f){0.f, 0.f, 0.f, 0.f};
    }
    float gam = 1.f;
    if (MT == 0) gam = sigmoidf_(p.in[I_RETL][(l * 2 + dir) * 4 + hh]);
    const int ti = tid >> 4, sub = tid & 15, c0 = sub * 8, ch = hh * 128 + c0;
    for (int b0 = 0; b0 < L; b0 += NB) {
        __syncthreads();
        {
            const int st = b0 + ti, pos = dir ? L - 1 - st : st, tok = tok0 + pos;
            const bf16_t* row = PROJ + (size_t)tok * PW;
            float q[8], k[8], v[8];
            if (MT == 0) {
                unpack8(*(const v4u*)(row + ch), q); unpack8(*(const v4u*)(row + 512 + ch), k); unpack8(*(const v4u*)(row + 1024 + ch), v);
                if (samp) {
                    float qp[8], kp[8]; unpack8(*(const v4u*)(row + (ch ^ 64)), qp); unpack8(*(const v4u*)(row + 512 + (ch ^ 64)), kp);
                    const float* RC = (const float*)(ws + WS_ROPE) + pos * 64 + (c0 & 63); const float* RS = RC + 65536;
#pragma unroll
                    for (int i = 0; i < 8; ++i) { const float cs = RC[i], sn = RS[i];
                        if (sub < 8) { q[i] = q[i] * cs - qp[i] * sn; k[i] = k[i] * cs - kp[i] * sn; }
                        else { q[i] = qp[i] * sn + q[i] * cs; k[i] = kp[i] * sn + k[i] * cs; } }
                }
#pragma unroll
                for (int i = 0; i < 8; ++i) k[i] *= HD_SCALE;
            } else if (MT == 1) {
                const float* cw = p.in[I_GCONV] + (size_t)l * 3 * 1536 + ch;
                const bool hm = pos > 0, hp = pos + 1 < L;
#pragma unroll
                for (int part = 0; part < 3; ++part) {
                    float xm[8], x0[8], xp[8]; const bf16_t* src = row + (4 + part) * 512 + ch;
                    unpack8(*(const v4u*)src, x0);
                    if (hm) unpack8(*(const v4u*)(src - PW), xm); else {
#pragma unroll
                        for (int i = 0; i < 8; ++i) xm[i] = 0.f; }
                    if (hp) unpack8(*(const v4u*)(src + PW), xp); else {
#pragma unroll
                        for (int i = 0; i < 8; ++i) xp[i] = 0.f; }
                    const float* w = cw + part * 512;
#pragma unroll
                    for (int i = 0; i < 8; ++i) { const float y = xm[i] * w[i] + x0[i] * w[1536 + i] + xp[i] * w[3072 + i]; const float s = siluf_(y);
                        if (part == 0) q[i] = s; else if (part == 1) k[i] = s; else v[i] = s; }
                }
                float sq = 0.f, sk = 0.f;
#pragma unroll
                for (int i = 0; i < 8; ++i) { sq += q[i] * q[i]; sk += k[i] * k[i]; }
                sq = row16_sum(sq); sk = row16_sum(sk);
                const float rq = rsqrtf(sq + EPSN) * HD_SCALE, rk = rsqrtf(sk + EPSN);
                float kq = 0.f;
#pragma unroll
                for (int i = 0; i < 8; ++i) { q[i] *= rq; k[i] *= rk; kq += q[i] * k[i]; }
                kq = row16_sum(kq);
                if (sub == 0) {
                    const float* AB = (const float*)(ws + WS_AB) + (size_t)tok * 16;
                    const float ap = AB[dir * 4 + hh] + p.in[I_GDTB][(l * 2 + dir) * 4 + hh], bp = AB[8 + dir * 4 + hh];
                    const float sp = fmaxf(ap, 0.f) + log1pf(expf(-fabsf(ap)));
                    const float alpha = expf(-expf(p.in[I_GALOG][(l * 2 + dir) * 4 + hh]) * sp);
                    *(LAS v4f*)(scl + ti * 4) = (v4f){alpha, sigmoidf_(bp), kq, 0.f};
                }
            } else {
                float fx[8], f[8]; unpack8(*(const v4u*)(row + 8 * 512 + ch), q); unpack8(*(const v4u*)(row + (9 + dir) * 512 + ch), fx); unpack8(*(const v4u*)(row + 11 * 512 + ch), v);
                const float* LB = (const float*)(ws + WS_LB) + (l * 2 + dir) * 512 + ch;
#pragma unroll
                for (int i = 0; i < 8; ++i) { const float lb = LB[i]; q[i] = siluf_(q[i]) * HD_SCALE; f[i] = lb + (1.0f - lb) * sigmoidf_(fx[i]); k[i] = (1.0f - lb) * sigmoidf_(-fx[i]); }
                *(LAS v4f*)(fs + ti * 128 + c0) = (v4f){f[0], f[1], f[2], f[3]}; *(LAS v4f*)(fs + ti * 128 + c0 + 4) = (v4f){f[4], f[5], f[6], f[7]};
            }
            *(LAS v4f*)(qs + ti * 128 + c0) = (v4f){q[0], q[1], q[2], q[3]}; *(LAS v4f*)(qs + ti * 128 + c0 + 4) = (v4f){q[4], q[5], q[6], q[7]};
            *(LAS v4f*)(ks + ti * 128 + c0) = (v4f){k[0], k[1], k[2], k[3]}; *(LAS v4f*)(ks + ti * 128 + c0 + 4) = (v4f){k[4], k[5], k[6], k[7]};
            *(LAS v4f*)(vs + ti * 128 + c0) = (v4f){v[0], v[1], v[2], v[3]}; *(LAS v4f*)(vs + ti * 128 + c0 + 4) = (v4f){v[4], v[5], v[6], v[7]};
        }
        __syncthreads();
#pragma unroll 2
        for (int i = 0; i < NB; ++i) {
            const v4f ka = *(const LAS v4f*)(ks + i * 128 + d0), kb = *(const LAS v4f*)(ks + i * 128 + d0 + 4);
            const v4f qa = *(const LAS v4f*)(qs + i * 128 + d0), qb = *(const LAS v4f*)(qs + i * 128 + d0 + 4);
            const v4f vv = *(const LAS v4f*)(vs + i * 128 + e0);
            const float kk[8] = {ka.x, ka.y, ka.z, ka.w, kb.x, kb.y, kb.z, kb.w};
            const float qq[8] = {qa.x, qa.y, qa.z, qa.w, qb.x, qb.y, qb.z, qb.w};
            v4f o = (v4f){0.f, 0.f, 0.f, 0.f};
            if (MT == 0) {
#pragma unroll
                for (int d = 0; d < 8; ++d) { S[d] = S[d] * gam + vv * kk[d]; o += S[d] * qq[d]; }
            } else if (MT == 2) {
                const v4f fa = *(const LAS v4f*)(fs + i * 128 + d0), fb = *(const LAS v4f*)(fs + i * 128 + d0 + 4);
                const float ff[8] = {fa.x, fa.y, fa.z, fa.w, fb.x, fb.y, fb.z, fb.w};
#pragma unroll
                for (int d = 0; d < 8; ++d) { S[d] = S[d] * ff[d] + vv * kk[d]; o += S[d] * qq[d]; }
            } else {
                const v4f sc4 = *(const LAS v4f*)(scl + i * 4);
                v4f r = (v4f){0.f, 0.f, 0.f, 0.f};
#pragma unroll
                for (int d = 0; d < 8; ++d) { S[d] = S[d] * sc4.x; r += S[d] * kk[d]; o += S[d] * qq[d]; }
                r.x = row16_sum(r.x); r.y = row16_sum(r.y); r.z = row16_sum(r.z); r.w = row16_sum(r.w);
                const v4f vn = (vv - r) * sc4.y;
#pragma unroll
                for (int d = 0; d < 8; ++d) S[d] += vn * kk[d];
                o.x = row16_sum(o.x); o.y = row16_sum(o.y); o.z = row16_sum(o.z); o.w = row16_sum(o.w);
                o += vn * sc4.z;
            }
            if (MT != 1) { o.x = row16_sum(o.x); o.y = row16_sum(o.y); o.z = row16_sum(o.z); o.w = row16_sum(o.w); }
            if (dg == 0) { const int st = b0 + i, pos = dir ? L - 1 - st : st; *(v4f*)(OB + (size_t)(tok0 + pos) * DM) = o; }
        }
    }
    if (!samp) { float* so = p.out + (MT == 0 ? O_RET : (MT == 1 ? O_GDN : O_HG)) + ((((size_t)seq * 2 + l) * 2 + dir) * 4 + hh) * 16384;
#pragma unroll
        for (int i = 0; i < 8; ++i) *(v4f*)(so + (d0 + i) * 128 + e0) = S[i]; }
}

DEV void s5_task(const Params& p, int l, int seq, int g, int dir, LAS float* wl) {
    const int lane = lane_id_();
    const int L = seq_len(seq), tok0 = seq_tok0(seq); const bool samp = seq >= 16;
    unsigned char* ws = p.ws;
    const bf16_t* PROJ = (const bf16_t*)(ws + WS_PROJ) + 13 * 512 + g * 16;
    float* OB = (float*)(ws + WS_OBUF) + (size_t)dir * T_TOK * DM + 1536 + g * 16;
    LAS float* xs = wl; LAS float* us = wl + 16 * 132;
    const int cg_ = (l * 2 + dir) * 32 + g, idx = cg_ * 64 + lane;
    const float ar = ((const float*)(ws + WS_S5A))[idx], ai = ((const float*)(ws + WS_S5A))[8192 + idx];
    float bbr[16], bbi[16];
    { const float* BR = (const float*)(ws + WS_S5B) + (size_t)idx * 16; const float* BI = BR + 131072;
#pragma unroll
        for (int c4 = 0; c4 < 4; ++c4) { const v4f a = *(const v4f*)(BR + c4 * 4), b = *(const v4f*)(BI + c4 * 4);
            bbr[c4 * 4] = a.x; bbr[c4 * 4 + 1] = a.y; bbr[c4 * 4 + 2] = a.z; bbr[c4 * 4 + 3] = a.w; bbi[c4 * 4] = b.x; bbi[c4 * 4 + 1] = b.y; bbi[c4 * 4 + 2] = b.z; bbi[c4 * 4 + 3] = b.w; } }
    float Areg[32];
    { const float* CR = p.in[I_SCRE] + (size_t)cg_ * 1024 + (lane & 15) * 64; const float* CI = p.in[I_SCIM] + (size_t)cg_ * 1024 + (lane & 15) * 64;
#pragma unroll
        for (int ks = 0; ks < 32; ++ks) { const int k = 4 * ks + (lane >> 4); Areg[ks] = ks < 16 ? CR[k] : -CI[k - 64]; } }
    float xr = 0.f, xi = 0.f;
    if (samp) { const size_t si = ((((size_t)(seq - 16) * 2 + l) * 2 + dir) * 32 + g) * 64 + lane; xr = p.in[I_S5RE][si]; xi = p.in[I_S5IM][si]; }
    for (int blk = 0; blk < L; blk += 16) {
        { const int st = blk + (lane >> 2), pos = dir ? L - 1 - st : st; const v2u w = *(const v2u*)(PROJ + (size_t)(tok0 + pos) * PW + (lane & 3) * 4);
          *(LAS v4f*)(us + (lane >> 2) * 16 + (lane & 3) * 4) = (v4f){lo_bf(w.x), hi_bf(w.x), lo_bf(w.y), hi_bf(w.y)}; }
        LDS_WAIT();
#pragma unroll 4
        for (int t = 0; t < 16; ++t) {
            float bur = 0.f, bui = 0.f;
#pragma unroll
            for (int c4 = 0; c4 < 4; ++c4) { const v4f u = *(const LAS v4f*)(us + t * 16 + c4 * 4);
                bur += bbr[c4 * 4] * u.x; bur += bbr[c4 * 4 + 1] * u.y; bur += bbr[c4 * 4 + 2] * u.z; bur += bbr[c4 * 4 + 3] * u.w;
                bui += bbi[c4 * 4] * u.x; bui += bbi[c4 * 4 + 1] * u.y; bui += bbi[c4 * 4 + 2] * u.z; bui += bbi[c4 * 4 + 3] * u.w; }
            const float nr = ar * xr - ai * xi + bur, ni = ar * xi + ai * xr + bui; xr = nr; xi = ni;
            xs[t * 132 + lane] = xr; xs[t * 132 + 64 + lane] = xi;
        }
        LDS_WAIT();
        v4f a0 = (v4f){0.f, 0.f, 0.f, 0.f}, a1 = (v4f){0.f, 0.f, 0.f, 0.f};
#pragma unroll
        for (int ks = 0; ks < 32; ks += 2) {
            const float b0 = xs[(lane & 15) * 132 + 4 * ks + (lane >> 4)], b1 = xs[(lane & 15) * 132 + 4 * ks + 4 + (lane >> 4)];
            a0 = __builtin_amdgcn_mfma_f32_16x16x4f32(Areg[ks], b0, a0, 0, 0, 0);
            a1 = __builtin_amdgcn_mfma_f32_16x16x4f32(Areg[ks + 1], b1, a1, 0, 0, 0);
        }
        { const int st = blk + (lane & 15), pos = dir ? L - 1 - st : st; *(v4f*)(OB + (size_t)(tok0 + pos) * DM + (lane >> 4) * 4) = a0 + a1; }
        LDS_WAIT();
    }
    if (!samp) { const size_t so = ((((size_t)seq * 2 + l) * 2 + dir) * 32 + g) * 64 + lane; p.out[O_S5RE + so] = xr; p.out[O_S5IM + so] = xi; }
}

DEV void mixer_phase(const Params& p, int l, LAS unsigned char* lds, const int wave) {
    const int tid = wave * 64 + lane_id_();
    unsigned* ctr = (unsigned*)(p.ws + WS_CTL) + 64 * l;
    volatile LAS unsigned* slot = (volatile LAS unsigned*)(lds + LDS_BYTES - 64);
    for (;;) {
        __syncthreads();
        if (tid == 0) *slot = atomicAdd(ctr, 1u);
        __syncthreads();
        const int t = (int)*slot;
        if (t >= 768) break;
        int mt, seq, rem;
        if (t < 192) { mt = t >> 6; rem = t & 63; seq = 16 + (rem >> 3); }
        else if (t < 256) { mt = 3; rem = t - 192; seq = 16 + (rem >> 3); }
        else if (t < 640) { const int j = t - 256; mt = j >> 7; rem = j & 127; seq = rem >> 3; }
        else { mt = 3; rem = t - 640; seq = rem >> 3; }
        const int hh = (rem >> 1) & 3, dir = rem & 1;
        if (mt == 0) chain_task<0>(p, l, seq, hh, dir, (LAS float*)lds, wave);
        else if (mt == 1) chain_task<1>(p, l, seq, hh, dir, (LAS float*)lds, wave);
        else if (mt == 2) chain_task<2>(p, l, seq, hh, dir, (LAS float*)lds, wave);
        else s5_task(p, l, seq, (rem & 7) * 4 + (wave >> 1), wave & 1, (LAS float*)(lds + wave * 9472));
    }
}

DEV void post_phase(const Params& p, int l, const int wave) {
    const int lane = lane_id_();
    const int gw = blockIdx.x * NWAVES + wave, NGW = gridDim.x * NWAVES;
    unsigned char* ws = p.ws;
    const float* O0 = (const float*)(ws + WS_OBUF); const float* O1 = O0 + (size_t)T_TOK * DM;
    const int hc = (lane & 15) * 8;
    for (int row = gw; row < T_TOK; row += NGW) {
        const bf16_t* pr = (const bf16_t*)(ws + WS_PROJ) + (size_t)row * PW;
        bf16_t* mix = (bf16_t*)(ws + WS_HB) + (size_t)row * DM;
#pragma unroll
        for (int seg = 0; seg < 4; ++seg) {
            const int col = seg * 512 + lane * 8;
            const v4f a0 = *(const v4f*)(O0 + (size_t)row * DM + col), a1 = *(const v4f*)(O0 + (size_t)row * DM + col + 4);
            const v4f b0 = *(const v4f*)(O1 + (size_t)row * DM + col), b1 = *(const v4f*)(O1 + (size_t)row * DM + col + 4);
            float a[8] = {a0.x + b0.x, a0.y + b0.y, a0.z + b0.z, a0.w + b0.w, a1.x + b1.x, a1.y + b1.y, a1.z + b1.z, a1.w + b1.w};
            float o[8];
            if (seg < 3) {
                float g[8]; unpack8(*(const v4u*)(pr + (seg == 0 ? 3 : (seg == 1 ? 7 : 12)) * 512 + lane * 8), g);
                if (seg == 0) {
                    float s = 0.f;
#pragma unroll
                    for (int i = 0; i < 8; ++i) s += a[i];
                    const float mean = row16_sum(s) * (1.0f / 128.0f); float q = 0.f;
#pragma unroll
                    for (int i = 0; i < 8; ++i) { a[i] -= mean; q += a[i] * a[i]; }
                    const float rs = rsqrtf(row16_sum(q) * (1.0f / 128.0f) + EPSN);
#pragma unroll
                    for (int i = 0; i < 8; ++i) o[i] = a[i] * rs * siluf_(g[i]);
                } else {
                    const float* nw = p.in[seg == 1 ? I_GNW : I_HNW] + l * 128 + hc; float q = 0.f;
#pragma unroll
                    for (int i = 0; i < 8; ++i) q += a[i] * a[i];
                    const float rs = rsqrtf(row16_sum(q) * (1.0f / 128.0f) + EPSN);
#pragma unroll
                    for (int i = 0; i < 8; ++i) o[i] = a[i] * rs * nw[i] * siluf_(g[i]);
                }
                *(v4u*)(mix + col) = pack8(o);
            } else {
                float su[8]; unpack8(*(const v4u*)(pr + 13 * 512 + lane * 8), su);
                const float* dd = p.in[I_S5D] + l * 512 + lane * 8;
#pragma unroll
                for (int i = 0; i < 8; ++i) { const float y = a[i] + dd[i] * su[i]; const float u = 0.7978845608028654f * (y + 0.044715f * y * y * y);
                    o[i] = 0.5f * y * (1.0f + tanhf(u)); }
                *(v4u*)((bf16_t*)(ws + WS_Z) + (size_t)row * 512 + lane * 8) = pack8(o);
            }
        }
    }
}

#define PH_IN(k) (lo <= (k) && (k) < hi)
#define PH_SEAM(k) do { if (PH_IN(k) && PH_IN((k) + 1)) grid.sync(); } while (0)
template <int L_> DEV void layer_phases(const Params& p, LAS unsigned char* lds, cg::grid_group& grid, int lo, int hi, const int wave) {
    constexpr int l = L_, B = 1 + 9 * L_;
    unsigned char* ws = p.ws;
    const float* mod = (const float*)(ws + WS_MOD) + (size_t)l * 9 * NMOD;
    if (PH_IN(B + 0)) norm_phase<0>(p, l, wave);
    PH_SEAM(B + 0);
    if (PH_IN(B + 1)) {
        pg8::Gemm g{(const bf16_t*)(ws + WS_HB), (const bf16_t*)(ws + WS_WIN) + (size_t)l * PW * DM, T_TOK, PW, DM}; pg8::StaticOrder S; S.init(T_TOK, PW, gridDim.x, blockIdx.x);
        EpiProjBf16 E{(bf16_t*)(ws + WS_PROJ), PW};
        pg8::gemm_phase<EpiProjBf16, pg8::StaticOrder>(lds, g, S, E, nullptr, wave);
    }
    PH_SEAM(B + 1);
    if (PH_IN(B + 2)) mixer_phase(p, l, lds, wave);
    PH_SEAM(B + 2);
    if (PH_IN(B + 3)) post_phase(p, l, wave);
    PH_SEAM(B + 3);
    if (PH_IN(B + 4)) {
        pg8::Gemm g{(const bf16_t*)(ws + WS_Z), (const bf16_t*)(ws + WS_WGLU) + (size_t)l * 512 * 512, T_TOK, 512, 512}; pg8::StaticOrder S; S.init(T_TOK, 512, gridDim.x, blockIdx.x);
        EpiGlu E{(const bf16_t*)(ws + WS_Z), (bf16_t*)(ws + WS_HB), p.in[I_GLUB] + l * 512};
        pg8::gemm_phase<EpiGlu, pg8::StaticOrder>(lds, g, S, E, nullptr, wave);
    }
    PH_SEAM(B + 4);
    if (PH_IN(B + 5)) {
        pg8::Gemm g{(const bf16_t*)(ws + WS_HB), (const bf16_t*)(ws + WS_WOUT) + (size_t)l * DM * DM, T_TOK, DM, DM}; pg8::StaticOrder S; S.init(T_TOK, DM, gridDim.x, blockIdx.x);
        float* xr = (float*)(ws + WS_XRES);
        EpiResid E{l == 0 ? p.in[I_XP] : xr, l == 0 ? p.in[I_XS] : xr, l == 0 ? NTP : 0, xr, mod + 2 * DM};
        pg8::gemm_phase<EpiResid, pg8::StaticOrder>(lds, g, S, E, nullptr, wave);
    }
    PH_SEAM(B + 5);
    if (PH_IN(B + 6)) norm_phase<1>(p, l, wave);
    PH_SEAM(B + 6);
    if (PH_IN(B + 7)) {
        pg8::Gemm g{(const bf16_t*)(ws + WS_HB), (const bf16_t*)(ws + WS_W13) + (size_t)l * 2 * FFH * DM, T_TOK, 2 * FFH, DM}; pg8::StaticOrder S; S.init(T_TOK, 2 * FFH, gridDim.x, blockIdx.x);
        EpiGated E{(bf16_t*)(ws + WS_PROJ)};
        pg8::gemm_phase<EpiGated, pg8::StaticOrder>(lds, g, S, E, nullptr, wave);
    }
    PH_SEAM(B + 7);
    if (PH_IN(B + 8)) {
        pg8::Gemm g{(const bf16_t*)(ws + WS_PROJ), (const bf16_t*)(ws + WS_W2) + (size_t)l * DM * FFH, T_TOK, DM, FFH}; pg8::StaticOrder S; S.init(T_TOK, DM, gridDim.x, blockIdx.x);
        float* xr = (float*)(ws + WS_XRES);
        EpiResid E{xr, xr, 0, xr, mod + 5 * DM};
        pg8::gemm_phase<EpiResid, pg8::StaticOrder>(lds, g, S, E, nullptr, wave);
    }
    PH_SEAM(B + 8);
}
__global__ void __launch_bounds__(NTHREADS, 2) trunk_fwd(Params p) {
    extern __shared__ __attribute__((aligned(16))) unsigned char lds_raw[];
    LAS unsigned char* lds = (LAS unsigned char*)lds_raw;
    cg::grid_group grid = cg::this_grid();
    const int lo = p.ph_lo, hi = p.ph_hi;
    const int wave = __builtin_amdgcn_readfirstlane((int)(threadIdx.x >> 6));
    if (PH_IN(0)) phase0(p, lds, wave);
    PH_SEAM(0);
    layer_phases<0>(p, lds, grid, lo, hi, wave);
    layer_phases<1>(p, lds, grid, lo, hi, wave);
    if (PH_IN(19)) norm_phase<2>(p, 0, wave);
}

#ifndef N_LAUNCH_MODE
#define N_LAUNCH_MODE 0
#endif
extern "C" void kernel_launch(void* const* d_in, const int* in_sizes, int n_in, void* d_out, int out_size, void* d_ws, size_t ws_size, hipStream_t stream) {
    static int grid = 0;
    if (grid == 0) {
        if (n_in != 36 || ws_size < WS_END) { fprintf(stderr, "kernel_launch: expected 36 inputs and >= %zu bytes of workspace, got %d / %zu\n", (size_t)WS_END, n_in, ws_size); grid = -1; return; }
        int dev = 0, cus = 0, per_cu = 0;
        hipGetDevice(&dev); hipDeviceGetAttribute(&cus, hipDeviceAttributeMultiprocessorCount, dev);
        if (hipFuncSetAttribute((const void*)trunk_fwd, hipFuncAttributeMaxDynamicSharedMemorySize, LDS_BYTES) != hipSuccess) { fprintf(stderr, "kernel_launch: hipFuncSetAttribute failed\n"); grid = -1; return; }
        hipOccupancyMaxActiveBlocksPerMultiprocessor(&per_cu, (const void*)trunk_fwd, NTHREADS, LDS_BYTES);
        if (per_cu < 1) { fprintf(stderr, "kernel_launch: occupancy query says %d blocks per CU\n", per_cu); per_cu = 1; }
        (void)hipGetLastError();
        grid = cus;
    }
    if (grid < 0) return;
    hipMemsetAsync((char*)d_ws + WS_CTL, 0, 4096, stream);
    Params p{};
    for (int i = 0; i < 36; ++i) p.in[i] = (const float*)d_in[i];
    p.out = (float*)d_out; p.ws = (unsigned char*)d_ws;
#if N_LAUNCH_MODE == 1
    p.ph_lo = 0; p.ph_hi = 20;
    void* args[] = {&p};
    hipError_t e = hipLaunchCooperativeKernel((const void*)trunk_fwd, dim3(grid), dim3(NTHREADS), args, LDS_BYTES, stream);
    if (e != hipSuccess) fprintf(stderr, "cooperative launch failed: %s (grid %d)\n", hipGetErrorString(e), grid);
#else
    for (int ph = 0; ph < 20; ++ph) { p.ph_lo = ph; p.ph_hi = ph + 1; hipLaunchKernelGGL(trunk_fwd, dim3(grid), dim3(NTHREADS), LDS_BYTES, stream, p); }
#endif
}
```

```cpp
#include <hip/hip_runtime.h>
#include <hip/hip_cooperative_groups.h>
#include <cstdio>
namespace cg = cooperative_groups;
__device__ __forceinline__ int lane_id_() { int r; asm volatile("v_mbcnt_lo_u32_b32 %0, -1, 0\n\tv_mbcnt_hi_u32_b32 %0, -1, %0" : "=v"(r)); return r; }
namespace pg8 {
#define PG8_LAS __attribute__((address_space(3)))
typedef unsigned short bf16_t;
typedef short bf16x8 __attribute__((ext_vector_type(8)));
typedef float f32x4 __attribute__((ext_vector_type(4)));
typedef unsigned u32x4 __attribute__((ext_vector_type(4)));
constexpr int BM = 256, BK = 64, HALF = 128, HTB = HALF * BK * 2  , STAGE_BYTES = 8 * HTB, NXCD = 8, WGM = 8;

__host__ __device__ __forceinline__ int lds_byte(int r, int c) { const int st = (r >> 4) * 2 + (c >> 5), rr = r & 15, cc = c & 31, ob = rr * 64 + cc * 2; return st * 1024 + (ob ^ (((ob >> 9) & 1) << 5)); }
__host__ __device__ __forceinline__ void stage_rc(int b, int& R, int& C) { const int st = b / 1024, sb = b % 1024, swz = sb ^ (((sb >> 9) & 1) << 5); R = (st >> 1) * 16 + swz / 64; C = (st & 1) * 32 + (swz % 64) / 2; }
__host__ __device__ __forceinline__ int perm32(int rho) { const int n = rho >> 4, i = rho & 15; return 8 * (i >> 2) + 4 * n + (i & 3); }

struct Unit { int pm, pn; };
struct Gemm { const bf16_t* A; const bf16_t* Bt; int M, N, K; };

struct StaticOrder {
    int nM, nN, nwg, G, c;
    __host__ __device__ void init(int M, int N, int G_, int c_) { nM = M / BM; nN = N / BM; nwg = nM * nN; G = G_; c = c_; }
    __host__ __device__ bool next(int i, Unit& u) const {
        const long L = (long)i * G + c; if (L >= nwg) return false;
        int wgid = (int)L; { const int q = nwg / NXCD, r = nwg % NXCD, xcd = wgid % NXCD, off = wgid / NXCD; wgid = (xcd < r ? xcd * (q + 1) : r * (q + 1) + (xcd - r) * q) + off; }
        const int nig = WGM * nN, gid = wgid / nig, fm = gid * WGM, gsz = (nM - fm) < WGM ? (nM - fm) : WGM;
        u.pm = fm + ((wgid % nig) % gsz); u.pn = (wgid % nig) / gsz; return true;
    }
    __device__ __forceinline__ void a_ready(const Unit&) const {}
    __device__ __forceinline__ void done(const Unit&) const {}
};
__device__ __forceinline__ unsigned cvt_pk_bf16(float lo, float hi) { unsigned r; asm volatile("v_cvt_pk_bf16_f32 %0, %1, %2" : "=v"(r) : "v"(lo), "v"(hi)); return r; }
typedef float f32x2 __attribute__((ext_vector_type(2)));
template <class Epi, class Sched, bool STAMP = false>
__device__ __forceinline__ void gemm_phase(PG8_LAS unsigned char* lds, const Gemm g, const Sched& S, const Epi& E, unsigned long long* stamps, const int wave_in) {
    const int wid = wave_in, lane = lane_id_(), tid = wid * 64 + lane, wr = wid >> 2, wc = wid & 3, fr = lane & 15, fq = lane >> 4;
    const int K = g.K, nt = K / BK;
    int ts_lo = 0, ts_hi = 0, nts = 0; const unsigned long long rt_entry = STAMP ? (unsigned long long)wall_clock64() : 0ull;
#define PG8_STAMP() do { if (STAMP && wid == 0 && nts < 64) { const unsigned long long _c = (unsigned long long)clock64(); \
        ts_lo = (lane == nts) ? (int)(unsigned)_c : ts_lo; ts_hi = (lane == nts) ? (int)(unsigned)(_c >> 32) : ts_hi; ++nts; } } while (0)
    PG8_STAMP();
    unsigned voffA[2], voffB[2];
#pragma unroll
    for (int i = 0; i < 2; ++i) { int R, C; stage_rc(tid * 16 + i * 8192, R, C); const int Rb = Epi::PERM ? ((R & ~31) + perm32(R & 31)) : R;
        voffA[i] = (unsigned)(R * K + C) * 2u; voffB[i] = (unsigned)(Rb * K + C) * 2u; }
    const size_t kstep = (size_t)(BK * 2);
    const size_t hstep = (size_t)HALF * K * 2;
    const size_t tstep = 2 * hstep;
    const unsigned ldsw = (unsigned)wid * 1024u;
    const int aoff = lds_byte(wr * 64 + fr, fq * 8), boff = lds_byte(wc * 32 + fr, fq * 8);
#define PG8_SA(b, h) (((b) * 2 + (h)) * HTB)
#define PG8_SB(b, h) ((4 + (b) * 2 + (h)) * HTB)
#define PG8_STAGE(bufoff, gbase, voff) do { _Pragma("unroll") for (int _i = 0; _i < 2; ++_i) \
        __builtin_amdgcn_global_load_lds((const unsigned*)((const char*)(gbase) + (voff)[_i]), (PG8_LAS unsigned*)(lds + (bufoff) + ldsw + _i * 8192), 16, 0, 0); } while (0)
#define PG8_LDA(dst, b, h) do { _Pragma("unroll") for (int m = 0; m < 4; ++m) _Pragma("unroll") for (int k = 0; k < 2; ++k) dst[m][k] = *(const PG8_LAS bf16x8*)(lds + PG8_SA(b, h) + aoff + m * 2048 + k * 1024); } while (0)
#define PG8_LDB(dst, b, h) do { _Pragma("unroll") for (int n = 0; n < 2; ++n) _Pragma("unroll") for (int k = 0; k < 2; ++k) dst[n][k] = *(const PG8_LAS bf16x8*)(lds + PG8_SB(b, h) + boff + n * 2048 + k * 1024); } while (0)
#define PG8_MMA(ai, bj, At, Bt) do { __builtin_amdgcn_s_setprio(1); _Pragma("unroll") for (int m = 0; m < 4; ++m) _Pragma("unroll") for (int n = 0; n < 2; ++n) _Pragma("unroll") for (int k = 0; k < 2; ++k) \
        acc[ai][bj][m][n] = __builtin_amdgcn_mfma_f32_16x16x32_bf16(Bt[n][k], At[m][k], acc[ai][bj][m][n], 0, 0, 0); __builtin_amdgcn_s_setprio(0); } while (0)
#define PG8_WAIT_V(n) asm volatile("s_waitcnt vmcnt(" #n ")" ::: "memory")
#define PG8_WAIT_L(n) asm volatile("s_waitcnt lgkmcnt(" #n ")" ::: "memory")
#define PG8_BAR __builtin_amdgcn_s_barrier()
#define PG8_SCHED __builtin_amdgcn_sched_barrier(0)
    Unit cur, nxt; int ui = 0;
    if (!S.next(0, cur)) return;
    f32x4 acc[2][2][4][2];
#pragma unroll
    for (int a = 0; a < 2; ++a)
#pragma unroll
        for (int b = 0; b < 2; ++b)
#pragma unroll
            for (int m = 0; m < 4; ++m)
#pragma unroll
                for (int n = 0; n < 2; ++n) acc[a][b][m][n] = (f32x4){0.f, 0.f, 0.f, 0.f};
    bf16x8 At[4][2], B0[2][2], B1[2][2];
    const char* cA = (const char*)g.A + (size_t)cur.pm * tstep; const char* cB = (const char*)g.Bt + (size_t)cur.pn * tstep;
    S.a_ready(cur);
    PG8_STAGE(PG8_SB(0, 0), cB, voffB); PG8_STAGE(PG8_SA(0, 0), cA, voffA); PG8_STAGE(PG8_SB(0, 1), cB + hstep, voffB); PG8_STAGE(PG8_SA(0, 1), cA + hstep, voffA);
    if (wr == 1) PG8_BAR;
    PG8_WAIT_V(4); PG8_BAR;
    PG8_STAGE(PG8_SB(1, 0), cB + kstep, voffB); PG8_STAGE(PG8_SA(1, 0), cA + kstep, voffA); PG8_STAGE(PG8_SB(1, 1), cB + hstep + kstep, voffB);
    PG8_WAIT_V(6); PG8_BAR;
    PG8_STAMP();
    for (;;) {
        const bool has_next = S.next(ui + 1, nxt);
        const char* nA = has_next ? (const char*)g.A + (size_t)nxt.pm * tstep : cA; const char* nB = has_next ? (const char*)g.Bt + (size_t)nxt.pn * tstep : cB;
        for (int t = 0; t < nt; t += 2) {
            const bool last = (t == nt - 2);
            const char* a1 = cA + (size_t)(t + 1) * kstep;
            const char* a2 = last ? nA : cA + (size_t)(t + 2) * kstep; const char* b2 = last ? nB : cB + (size_t)(t + 2) * kstep;
            const char* a3 = a2 + kstep; const char* b3 = b2 + kstep;
            if (last && has_next) S.a_ready(nxt);
            PG8_LDB(B0, 0, 0); PG8_SCHED; PG8_LDA(At, 0, 0); PG8_STAGE(PG8_SA(1, 1), a1 + hstep, voffA);
            PG8_WAIT_L(8); PG8_BAR; PG8_WAIT_L(0); PG8_MMA(0, 0, At, B0); PG8_BAR; PG8_SCHED;
            PG8_LDB(B1, 0, 1); PG8_STAGE(PG8_SB(0, 0), b2, voffB);
            PG8_BAR; PG8_WAIT_L(0); PG8_MMA(0, 1, At, B1); PG8_BAR;
            PG8_LDA(At, 0, 1); PG8_STAGE(PG8_SA(0, 0), a2, voffA);
            PG8_BAR; PG8_WAIT_L(0); PG8_MMA(1, 0, At, B0); PG8_BAR; PG8_SCHED;
            PG8_STAGE(PG8_SB(0, 1), b2 + hstep, voffB);
            PG8_WAIT_V(6); PG8_BAR; PG8_MMA(1, 1, At, B1); PG8_BAR;
            PG8_LDB(B0, 1, 0); PG8_SCHED; PG8_LDA(At, 1, 0); PG8_STAGE(PG8_SA(0, 1), a2 + hstep, voffA);
            PG8_WAIT_L(8); PG8_BAR; PG8_WAIT_L(0); PG8_MMA(0, 0, At, B0); PG8_BAR; PG8_SCHED;
            PG8_LDB(B1, 1, 1); PG8_STAGE(PG8_SB(1, 0), b3, voffB);
            PG8_BAR; PG8_WAIT_L(0); PG8_MMA(0, 1, At, B1); PG8_BAR;
            PG8_LDA(At, 1, 1); PG8_STAGE(PG8_SA(1, 0), a3, voffA);
            PG8_BAR; PG8_WAIT_L(0); PG8_MMA(1, 0, At, B0); PG8_BAR; PG8_SCHED;
            PG8_STAGE(PG8_SB(1, 1), b3 + hstep, voffB);
            PG8_WAIT_V(6); PG8_BAR; PG8_MMA(1, 1, At, B1); PG8_BAR;
        }
        PG8_STAMP();
        if constexpr (!Epi::AFTER_DRAIN) { E(acc, cur, wr, wc, fr, fq); S.done(cur); }
        PG8_STAMP();
        if (!has_next) break;
#pragma unroll
        for (int a = 0; a < 2; ++a)
#pragma unroll
            for (int b = 0; b < 2; ++b)
#pragma unroll
                for (int m = 0; m < 4; ++m)
#pragma unroll
                    for (int n = 0; n < 2; ++n) acc[a][b][m][n] = (f32x4){0.f, 0.f, 0.f, 0.f};
        cur = nxt; cA = nA; cB = nB; ++ui;
    }
    PG8_WAIT_V(0);
    if (wr == 0) PG8_BAR;
    PG8_BAR;
    if constexpr (Epi::AFTER_DRAIN) { E.fused(acc, cur, wr, wc, fr, fq, lds, wid, lane); S.done(cur); }
    PG8_STAMP();
    if (STAMP && wid == 0) { stamps[lane] = lane < nts ? (((unsigned long long)(unsigned)ts_hi << 32) | (unsigned)ts_lo) : 0ull;
        if (lane == 62) stamps[62] = rt_entry; if (lane == 63) stamps[63] = (unsigned long long)wall_clock64(); }
#undef PG8_STAMP
#undef PG8_SA
#undef PG8_SB
#undef PG8_STAGE
#undef PG8_LDA
#undef PG8_LDB
#undef PG8_MMA
#undef PG8_WAIT_V
#undef PG8_WAIT_L
#undef PG8_BAR
#undef PG8_SCHED
}
}

#define LAS __attribute__((address_space(3)))
#define DEV __device__ __forceinline__
typedef unsigned short bf16_t;
typedef float v4f __attribute__((ext_vector_type(4)));
typedef float v2f __attribute__((ext_vector_type(2)));
typedef unsigned v4u __attribute__((ext_vector_type(4)));
typedef unsigned v2u __attribute__((ext_vector_type(2)));

constexpr int T_TOK = 12288, NTP = 4096, DM = 2048, PW = 7168, FFH = 5632, NMOD = 12288;
constexpr int NTHREADS = 512, NWAVES = 8;
constexpr int LDS_BYTES = 131072;
constexpr float EPSN = 1e-6f;
constexpr float HD_SCALE = 0.08838834764831845f;

constexpr size_t WS_CTL = 0;
constexpr size_t WS_MOD = 4096;
constexpr size_t WS_LB = WS_MOD + (size_t)2 * 9 * NMOD * 4;
constexpr size_t WS_S5A = WS_LB + 2 * 2 * 512 * 4;
constexpr size_t WS_S5B = WS_S5A + 2 * 8192 * 4;
constexpr size_t WS_ROPE = WS_S5B + 2 * 131072 * 4;
constexpr size_t WS_AB = WS_ROPE + 2 * 65536 * 4;
constexpr size_t WS_WABT = WS_AB + (size_t)T_TOK * 16 * 4;
constexpr size_t WS_WIN = WS_WABT + (size_t)2 * 16 * DM * 4;
constexpr size_t WS_WOUT = WS_WIN + (size_t)2 * PW * DM * 2;
constexpr size_t WS_W13 = WS_WOUT + (size_t)2 * DM * DM * 2;
constexpr size_t WS_W2 = WS_W13 + (size_t)2 * 2 * FFH * DM * 2;
constexpr size_t WS_WGLU = WS_W2 + (size_t)2 * DM * FFH * 2;
constexpr size_t WS_HB = WS_WGLU + (size_t)2 * 512 * 512 * 2;
constexpr size_t WS_Z = WS_HB + (size_t)T_TOK * DM * 2;
constexpr size_t WS_XRES = WS_Z + (size_t)T_TOK * 512 * 2;
constexpr size_t WS_PROJ = WS_XRES + (size_t)T_TOK * DM * 4;
constexpr size_t WS_OBUF = WS_PROJ + (size_t)T_TOK * PW * 2;
constexpr size_t WS_END = WS_OBUF + (size_t)2 * T_TOK * DM * 4;

struct Params { const float* in[36]; float* out; unsigned char* ws; int ph_lo, ph_hi; };
enum { I_XP = 0, I_XS, I_SRET, I_SGDN, I_SHG, I_S5RE, I_S5IM, I_C, I_CCTX, I_N1W, I_N2W, I_FNW, I_ADAW, I_ADAB, I_INP, I_OUTP, I_RETL, I_GCONV, I_GALOG, I_GDTB,
       I_GNW, I_HLB, I_HNW, I_SARE, I_SAIM, I_SBRE, I_SBIM, I_SCRE, I_SCIM, I_SLOG, I_S5D, I_GLUW, I_GLUB, I_W1, I_W3, I_W2 };
constexpr size_t O_Y = 0;
constexpr size_t O_RET = (size_t)T_TOK * DM;
constexpr size_t O_GDN = O_RET + 4194304;
constexpr size_t O_HG = O_GDN + 4194304;
constexpr size_t O_S5RE = O_HG + 4194304;
constexpr size_t O_S5IM = O_S5RE + 131072;

DEV float bf2f(bf16_t v) { return __uint_as_float(((unsigned)v) << 16); }
DEV unsigned pk2(float lo, float hi) { unsigned r; asm volatile("v_cvt_pk_bf16_f32 %0, %1, %2" : "=v"(r) : "v"(lo), "v"(hi)); return r; }
DEV void mfma_fence(v4f& x) { asm volatile("s_nop 15\n\ts_nop 15" : "+v"(x)); }
DEV void mfma_fence8(v4f (&a)[8]) { asm volatile("s_nop 15\n\ts_nop 15" : "+v"(a[0]), "+v"(a[1]), "+v"(a[2]), "+v"(a[3]), "+v"(a[4]), "+v"(a[5]), "+v"(a[6]), "+v"(a[7])); }
DEV float lo_bf(unsigned w) { return __uint_as_float(w << 16); }
DEV float hi_bf(unsigned w) { return __uint_as_float(w & 0xffff0000u); }
DEV void unpack8(v4u w, float (&f)[8]) { f[0] = lo_bf(w.x); f[1] = hi_bf(w.x); f[2] = lo_bf(w.y); f[3] = hi_bf(w.y); f[4] = lo_bf(w.z); f[5] = hi_bf(w.z); f[6] = lo_bf(w.w); f[7] = hi_bf(w.w); }
DEV v4u pack8(const float (&f)[8]) { v4u w; w.x = pk2(f[0], f[1]); w.y = pk2(f[2], f[3]); w.z = pk2(f[4], f[5]); w.w = pk2(f[6], f[7]); return w; }
DEV float sigmoidf_(float x) { return __builtin_amdgcn_rcpf(1.0f + __expf(-x)); }
DEV float siluf_(float x) { return x * sigmoidf_(x); }
template <int CTRL> DEV float dppf(float v) { return __builtin_bit_cast(float, __builtin_amdgcn_update_dpp(0, __builtin_bit_cast(int, v), CTRL, 0xf, 0xf, false)); }
DEV float row16_sum(float v) {
    v += dppf<0xB1>(v); v += dppf<0x4E>(v); v += dppf<0x141>(v); v += dppf<0x140>(v); return v;
}
DEV float wave_sum(float v) { v = row16_sum(v); v += __shfl_xor(v, 16); v += __shfl_xor(v, 32); return v; }
#define LDS_WAIT() asm volatile("s_waitcnt lgkmcnt(0)" ::: "memory")
DEV int seq_len(int seq) { return seq < 16 ? 256 : 1024; }
DEV int seq_tok0(int seq) { return seq < 16 ? seq * 256 : NTP + (seq - 16) * 1024; }
DEV int mod_row_of(int row) { return row < NTP ? 0 : 1 + ((row - NTP) >> 10); }

struct EpiProjBf16 {
    static constexpr bool PERM = true, AFTER_DRAIN = false;
    bf16_t* O; int ldc;
    DEV void operator()(const pg8::f32x4 (&acc)[2][2][4][2], const pg8::Unit& u, int wr, int wc, int fr, int fq) const {
        const int row0 = u.pm * 256 + wr * 64 + fr, col0 = u.pn * 256 + wc * 32 + 8 * fq;
#pragma unroll
        for (int ai = 0; ai < 2; ++ai)
#pragma unroll
            for (int m = 0; m < 4; ++m) { bf16_t* rowp = O + (size_t)(row0 + ai * 128 + m * 16) * ldc + col0;
#pragma unroll
                for (int bj = 0; bj < 2; ++bj) { const pg8::f32x4 v0 = acc[ai][bj][m][0], v1 = acc[ai][bj][m][1];
                    v4u w; w.x = pk2(v0[0], v0[1]); w.y = pk2(v0[2], v0[3]); w.z = pk2(v1[0], v1[1]); w.w = pk2(v1[2], v1[3]);
                    *(v4u*)(rowp + bj * 128) = w; } }
    }
};
struct EpiGated {
    static constexpr bool PERM = true, AFTER_DRAIN = false;
    bf16_t* O;
    DEV void operator()(const pg8::f32x4 (&acc)[2][2][4][2], const pg8::Unit& u, int wr, int wc, int fr, int fq) const {
        const int row0 = u.pm * 256 + wr * 64 + fr, col0 = u.pn * 128 + wc * 32 + 8 * fq;
#pragma unroll
        for (int ai = 0; ai < 2; ++ai)
#pragma unroll
            for (int m = 0; m < 4; ++m) { bf16_t* rowp = O + (size_t)(row0 + ai * 128 + m * 16) * FFH + col0;
                float f[8];
#pragma unroll
                for (int n = 0; n < 2; ++n)
#pragma unroll
                    for (int j = 0; j < 4; ++j) f[n * 4 + j] = siluf_(acc[ai][0][m][n][j]) * acc[ai][1][m][n][j];
                *(v4u*)rowp = pack8(f); }
    }
};
struct EpiResid {
    static constexpr bool PERM = false, AFTER_DRAIN = false;
    const float* bA; const float* bB; int rowoffB; float* out; const float* gate;
    DEV void operator()(const pg8::f32x4 (&acc)[2][2][4][2], const pg8::Unit& u, int wr, int wc, int fr, int fq) const {
        const int row0 = u.pm * 256 + wr * 64 + fr, col0 = u.pn * 256 + wc * 32 + 4 * fq;
        const int mr = u.pm < 16 ? 0 : 1 + ((u.pm - 16) >> 2);
        const float* g = gate + (size_t)mr * NMOD + col0;
        pg8::f32x4 gv[2][2];
#pragma unroll
        for (int bj = 0; bj < 2; ++bj)
#pragma unroll
            for (int n = 0; n < 2; ++n) gv[bj][n] = *(const pg8::f32x4*)(g + bj * 128 + n * 16);
#pragma unroll
        for (int ai = 0; ai < 2; ++ai)
#pragma unroll
            for (int m = 0; m < 4; ++m) { const int r = row0 + ai * 128 + m * 16;
                const float* bp = (r < NTP ? bA + (size_t)r * DM : bB + (size_t)(r - rowoffB) * DM) + col0; float* op = out + (size_t)r * DM + col0;
#pragma unroll
                for (int bj = 0; bj < 2; ++bj)
#pragma unroll
                    for (int n = 0; n < 2; ++n) { const pg8::f32x4 b = *(const pg8::f32x4*)(bp + bj * 128 + n * 16);
                        *(pg8::f32x4*)(op + bj * 128 + n * 16) = b + gv[bj][n] * acc[ai][bj][m][n]; } }
    }
};
struct EpiGlu {
    static constexpr bool PERM = true, AFTER_DRAIN = false;
    const bf16_t* Z; bf16_t* MIX; const float* bias;
    DEV void operator()(const pg8::f32x4 (&acc)[2][2][4][2], const pg8::Unit& u, int wr, int wc, int fr, int fq) const {
        const int row0 = u.pm * 256 + wr * 64 + fr, col0 = u.pn * 256 + wc * 32 + 8 * fq;
#pragma unroll
        for (int bj = 0; bj < 2; ++bj) { const int c = col0 + bj * 128;
            const v4f b0 = *(const v4f*)(bias + c), b1 = *(const v4f*)(bias + c + 4);
#pragma unroll
            for (int ai = 0; ai < 2; ++ai)
#pragma unroll
                for (int m = 0; m < 4; ++m) { const int r = row0 + ai * 128 + m * 16;
                    float z[8]; unpack8(*(const v4u*)(Z + (size_t)r * 512 + c), z);
                    float f[8];
#pragma unroll
                    for (int j = 0; j < 4; ++j) { f[j] = z[j] * sigmoidf_(acc[ai][bj][m][0][j] + b0[j]); f[4 + j] = z[4 + j] * sigmoidf_(acc[ai][bj][m][1][j] + b1[j]); }
                    *(v4u*)(MIX + (size_t)r * DM + 1536 + c) = pack8(f); } }
    }
};

DEV void tr_item(const float* W, int ldw, int srcc0, bf16_t* WT, int Kd, int dstr0, int k0, LAS float* scr, int lane) {
    {
        const int c4 = (lane & 7) * 4, kr = lane >> 3;
        v4f t[8];
#pragma unroll
        for (int i = 0; i < 8; ++i) t[i] = *(const v4f*)(W + (size_t)(k0 + kr + 8 * i) * ldw + srcc0 + c4);
#pragma unroll
        for (int i = 0; i < 8; ++i) { LAS float* d = scr + (kr + 8 * i) * 33 + c4; d[0] = t[i].x; d[1] = t[i].y; d[2] = t[i].z; d[3] = t[i].w; }
    }
    LDS_WAIT();
    const int c = lane & 7;
#pragma unroll
    for (int j = 0; j < 4; ++j) { const int n = (lane >> 3) + 8 * j; const LAS float* s = scr + (8 * c) * 33 + n;
        v4u o; o.x = pk2(s[0 * 33], s[1 * 33]); o.y = pk2(s[2 * 33], s[3 * 33]); o.z = pk2(s[4 * 33], s[5 * 33]); o.w = pk2(s[6 * 33], s[7 * 33]);
        *(v4u*)(WT + (size_t)(dstr0 + n) * Kd + k0 + 8 * c) = o; }
    LDS_WAIT();
}

DEV void phase0(const Params& p, LAS unsigned char* lds, const int wave) {
    const int lane = lane_id_(), tid = wave * 64 + lane;
    const int gtid = blockIdx.x * NTHREADS + tid, NT = gridDim.x * NTHREADS;
    unsigned char* ws = p.ws;
    {
        float* LB = (float*)(ws + WS_LB); const float* lp = p.in[I_HLB];
        for (int i = gtid; i < 1024; i += NT) { const float a = lp[i], b = lp[1024 + i], m = fmaxf(a, b); const float ea = expf(a - m), eb = expf(b - m);
            LB[i] = 0.f; LB[1024 + i] = eb / (ea + eb); }
    }
    {
        float* AR = (float*)(ws + WS_S5A); float* AI = AR + 8192; float* BR = (float*)(ws + WS_S5B); float* BI = BR + 131072;
        for (int i = gtid; i < 8192; i += NT) {
            const float are = p.in[I_SARE][i], aim = p.in[I_SAIM][i], dt = expf(p.in[I_SLOG][i >> 6]);
            const float mag = expf(are * dt); float sn, cs; sincosf(aim * dt, &sn, &cs);
            const float abr = mag * cs, abi = mag * sn; AR[i] = abr; AI[i] = abi;
            const float den = are * are + aim * aim, nr = abr - 1.0f;
            const float fre = (nr * are + abi * aim) / den, fim = (abi * are - nr * aim) / den;
            for (int c = 0; c < 16; ++c) { const float br = p.in[I_SBRE][i * 16 + c], bi = p.in[I_SBIM][i * 16 + c];
                BR[i * 16 + c] = fre * br - fim * bi; BI[i * 16 + c] = fre * bi + fim * br; }
        }
    }
    {
        float* RC = (float*)(ws + WS_ROPE); float* RS = RC + 65536;
        for (int i = gtid; i < 65536; i += NT) { const int pos = i >> 6, j = i & 63, fi = j & 31;
            const float inv = expf(-(float)fi * (9.210340371976184f / 32.0f)); const float t = (float)(j < 32 ? (pos >> 6) : (pos & 63));
            float sn, cs; sincosf(t * inv, &sn, &cs); RC[i] = cs; RS[i] = sn; }
    }
    {
        float* WT = (float*)(ws + WS_WABT);
        for (int i = gtid; i < 2 * 16 * DM; i += NT) { const int l = i >> 15, q = (i >> 11) & 15, c = i & 2047; WT[i] = p.in[I_INP][(size_t)l * DM * 7184 + (size_t)c * 7184 + 4096 + q]; }
    }
    if ((int)blockIdx.x < 192) {
        LAS float* sc = (LAS float*)lds;
        LAS float* red = (LAS float*)(lds + 73728);
        for (int i = tid; i < 9 * 2048; i += NTHREADS) { const int r = i >> 11, k = i & 2047; const float v = (r == 0) ? p.in[I_CCTX][k] : p.in[I_C][(r - 1) * 2048 + k]; sc[i] = siluf_(v); }
        __syncthreads();
        for (int item = blockIdx.x; item < 192; item += gridDim.x) {
            const int l = item / 96, j0 = (item % 96) * 128;
            const float* W = p.in[I_ADAW] + (size_t)l * DM * NMOD + j0 + lane * 2;
            v2f acc[9];
#pragma unroll
            for (int r = 0; r < 9; ++r) acc[r] = (v2f){0.f, 0.f};
            for (int k = wave * 256; k < wave * 256 + 256; k += 16) {
                v2f w[16];
#pragma unroll
                for (int q = 0; q < 16; ++q) w[q] = __builtin_nontemporal_load((const v2f*)(W + (size_t)(k + q) * NMOD));
#pragma unroll
                for (int q4 = 0; q4 < 4; ++q4)
#pragma unroll
                    for (int r = 0; r < 9; ++r) { const v4f s = *(const LAS v4f*)(sc + r * 2048 + k + 4 * q4);
                        acc[r] += w[4 * q4] * s.x; acc[r] += w[4 * q4 + 1] * s.y; acc[r] += w[4 * q4 + 2] * s.z; acc[r] += w[4 * q4 + 3] * s.w; }
            }
#pragma unroll
            for (int r = 0; r < 9; ++r) { red[(wave * 18 + r * 2) * 64 + lane] = acc[r].x; red[(wave * 18 + r * 2 + 1) * 64 + lane] = acc[r].y; }
            __syncthreads();
            for (int o = tid; o < 18 * 64; o += NTHREADS) { const int rr = o >> 6, ln = o & 63; float s = 0.f;
#pragma unroll
                for (int w = 0; w < 8; ++w) s += red[(w * 18 + rr) * 64 + ln];
                const int r = rr >> 1, j = j0 + ln * 2 + (rr & 1);
                ((float*)(ws + WS_MOD))[(size_t)(l * 9 + r) * NMOD + j] = s + p.in[I_ADAB][l * NMOD + j]; }
            __syncthreads();
        }
    }
    __syncthreads();
    {
        LAS float* scr = (LAS float*)(lds + wave * 8448);
        const int gw = blockIdx.x * NWAVES + wave, NGW = gridDim.x * NWAVES;
        constexpr int I_IN = 32 * 224, I_OUT = 32 * 64, I_13 = 32 * 352, I_2 = 88 * 64, I_G = 8 * 16, I_L = I_IN + I_OUT + I_13 + I_2 + I_G;
        for (int it = gw; it < 2 * I_L; it += NGW) {
            const int l = it / I_L; int r = it % I_L;
            if (r < I_IN) { const int kb = r / 224, nb = r % 224, n0 = nb * 32;
                tr_item(p.in[I_INP] + (size_t)l * DM * 7184, 7184, n0 < 4096 ? n0 : n0 + 16, (bf16_t*)(ws + WS_WIN) + (size_t)l * PW * DM, DM, n0, kb * 64, scr, lane); continue; }
            r -= I_IN;
            if (r < I_OUT) { const int kb = r / 64, nb = r % 64;
                tr_item(p.in[I_OUTP] + (size_t)l * DM * DM, DM, nb * 32, (bf16_t*)(ws + WS_WOUT) + (size_t)l * DM * DM, DM, nb * 32, kb * 64, scr, lane); continue; }
            r -= I_OUT;
            if (r < I_13) { const int kb = r / 352, nb = r % 352, n0 = nb * 32, tile = n0 >> 8, within = n0 & 255;
                const float* src = (within < 128 ? p.in[I_W1] : p.in[I_W3]) + (size_t)l * DM * FFH;
                tr_item(src, FFH, tile * 128 + (within & 127), (bf16_t*)(ws + WS_W13) + (size_t)l * 2 * FFH * DM, DM, n0, kb * 64, scr, lane); continue; }
            r -= I_13;
            if (r < I_2) { const int kb = r / 64, nb = r % 64;
                tr_item(p.in[I_W2] + (size_t)l * FFH * DM, DM, nb * 32, (bf16_t*)(ws + WS_W2) + (size_t)l * DM * FFH, FFH, nb * 32, kb * 64, scr, lane); continue; }
            r -= I_2;
            { const int kb = r / 16, nb = r % 16;
                tr_item(p.in[I_GLUW] + (size_t)l * 512 * 512, 512, nb * 32, (bf16_t*)(ws + WS_WGLU) + (size_t)l * 512 * 512, 512, nb * 32, kb * 64, scr, lane); }
        }
    }
}

template <int WHICH> DEV void norm_phase(const Params& p, int l, const int wave) {
    const int lane = lane_id_();
    const int gw = blockIdx.x * NWAVES + wave, NGW = gridDim.x * NWAVES;
    unsigned char* ws = p.ws;
    const float* XR = (const float*)(ws + WS_XRES);
    for (int row = gw; row < T_TOK; row += NGW) {
        const float* x;
        if (WHICH == 0 && l == 0) x = row < NTP ? p.in[I_XP] + (size_t)row * DM : p.in[I_XS] + (size_t)(row - NTP) * DM; else x = XR + (size_t)row * DM;
        v4f v[8]; float ss = 0.f;
#pragma unroll
        for (int j = 0; j < 8; ++j) { v[j] = *(const v4f*)(x + lane * 4 + 256 * j); ss += (v[j].x * v[j].x + v[j].y * v[j].y) + (v[j].z * v[j].z + v[j].w * v[j].w); }
        const float rstd = rsqrtf(wave_sum(ss) * (1.0f / DM) + EPSN);
        if (WHICH == 2) {
            const float* w = p.in[I_FNW]; float* o = p.out + O_Y + (size_t)row * DM;
#pragma unroll
            for (int j = 0; j < 8; ++j) { const v4f wv = *(const v4f*)(w + lane * 4 + 256 * j); *(v4f*)(o + lane * 4 + 256 * j) = v[j] * rstd * wv; }
        } else {
            const float* mod = (const float*)(ws + WS_MOD) + (size_t)(l * 9 + mod_row_of(row)) * NMOD;
            const float* shift = mod + (WHICH ? 3 : 0) * DM; const float* scale = mod + (WHICH ? 4 : 1) * DM;
            const float* w = p.in[WHICH ? I_N2W : I_N1W] + l * DM;
            bf16_t* o = (bf16_t*)(ws + WS_HB) + (size_t)row * DM;
#pragma unroll
            for (int j = 0; j < 8; ++j) { const int c = lane * 4 + 256 * j;
                const v4f wv = *(const v4f*)(w + c), sh = *(const v4f*)(shift + c), scl = *(const v4f*)(scale + c);
                const v4f h = v[j] * rstd * wv * (1.0f + scl) + sh; v[j] = h;
                v2u pk; pk.x = pk2(h.x, h.y); pk.y = pk2(h.z, h.w); *(v2u*)(o + c) = pk; }
            if (WHICH == 0) {
                const float* wt = (const float*)(ws + WS_WABT) + (size_t)l * 16 * DM + lane * 4; float mine = 0.f;
#pragma unroll 2
                for (int q = 0; q < 16; ++q) { float s = 0.f;
#pragma unroll
                    for (int j = 0; j < 8; ++j) { const v4f wq = *(const v4f*)(wt + q * DM + 256 * j); s += (v[j].x * wq.x + v[j].y * wq.y) + (v[j].z * wq.z + v[j].w * wq.w); }
                    s = wave_sum(s); mine = (lane == q) ? s : mine; }
                if (lane < 16) ((float*)(ws + WS_AB))[(size_t)row * 16 + lane] = mine;
            }
        }
    }
}

constexpr int NB = 32;
template <int MT> DEV void chain_task(const Params& p, int l, int seq, int hh, int dir, LAS float* lds, const int wave) {
    const int lane = lane_id_(), tid = wave * 64 + lane, dg = lane & 15, eg = lane >> 4;
    const int L = seq_len(seq), tok0 = seq_tok0(seq); const bool samp = seq >= 16;
    const int e0 = wave * 16 + eg * 4, d0 = dg * 8;
    unsigned char* ws = p.ws;
    const bf16_t* PROJ = (const bf16_t*)(ws + WS_PROJ);
    float* OB = (float*)(ws + WS_OBUF) + (size_t)dir * T_TOK * DM + MT * 512 + hh * 128 + e0;
    LAS float* qs = lds; LAS float* ks = lds + NB * 128; LAS float* vs = lds + 2 * NB * 128; LAS float* fs = lds + 3 * NB * 128; LAS float* scl = lds + 4 * NB * 128;
    v4f S[8];
    if (samp) { const float* st = p.in[MT == 0 ? I_SRET : (MT == 1 ? I_SGDN : I_SHG)] + ((((size_t)(seq - 16) * 2 + l) * 2 + dir) * 4 + hh) * 16384;
#pragma unroll
        for (int i = 0; i < 8; ++i) S[i] = *(const v4f*)(st + (d0 + i) * 128 + e0);
    } else {
#pragma unroll
        for (int i = 0; i < 8; ++i) S[i] = (v4f){0.f, 0.f, 0.f, 0.f};
    }
    float gam = 1.f;
    if (MT == 0) gam = sigmoidf_(p.in[I_RETL][(l * 2 + dir) * 4 + hh]);
    const int ti = tid >> 4, sub = tid & 15, c0 = sub * 8, ch = hh * 128 + c0;
    for (int b0 = 0; b0 < L; b0 += NB) {
        __syncthreads();
        {
            const int st = b0 + ti, pos = dir ? L - 1 - st : st, tok = tok0 + pos;
            const bf16_t* row = PROJ + (size_t)tok * PW;
            float q[8], k[8], v[8];
            if (MT == 0) {
                unpack8(*(const v4u*)(row + ch), q); unpack8(*(const v4u*)(row + 512 + ch), k); unpack8(*(const v4u*)(row + 1024 + ch), v);
                if (samp) {
                    float qp[8], kp[8]; unpack8(*(const v4u*)(row + (ch ^ 64)), qp); unpack8(*(const v4u*)(row + 512 + (ch ^ 64)), kp);
                    const float* RC = (const float*)(ws + WS_ROPE) + pos * 64 + (c0 & 63); const float* RS = RC + 65536;
#pragma unroll
                    for (int i = 0; i < 8; ++i) { const float cs = RC[i], sn = RS[i];
                        if (sub < 8) { q[i] = q[i] * cs - qp[i] * sn; k[i] = k[i] * cs - kp[i] * sn; }
                        else { q[i] = qp[i] * sn + q[i] * cs; k[i] = kp[i] * sn + k[i] * cs; } }
                }
#pragma unroll
                for (int i = 0; i < 8; ++i) k[i] *= HD_SCALE;
            } else if (MT == 1) {
                const float* cw = p.in[I_GCONV] + (size_t)l * 3 * 1536 + ch;
                const bool hm = pos > 0, hp = pos + 1 < L;
#pragma unroll
                for (int part = 0; part < 3; ++part) {
                    float xm[8], x0[8], xp[8]; const bf16_t* src = row + (4 + part) * 512 + ch;
                    unpack8(*(const v4u*)src, x0);
                    if (hm) unpack8(*(const v4u*)(src - PW), xm); else {
#pragma unroll
                        for (int i = 0; i < 8; ++i) xm[i] = 0.f; }
                    if (hp) unpack8(*(const v4u*)(src + PW), xp); else {
#pragma unroll
                        for (int i = 0; i < 8; ++i) xp[i] = 0.f; }
                    const float* w = cw + part * 512;
#pragma unroll
                    for (int i = 0; i < 8; ++i) { const float y = xm[i] * w[i] + x0[i] * w[1536 + i] + xp[i] * w[3072 + i]; const float s = siluf_(y);
                        if (part == 0) q[i] = s; else if (part == 1) k[i] = s; else v[i] = s; }
                }
                float sq = 0.f, sk = 0.f;
#pragma unroll
                for (int i = 0; i < 8; ++i) { sq += q[i] * q[i]; sk += k[i] * k[i]; }
                sq = row16_sum(sq); sk = row16_sum(sk);
                const float rq = rsqrtf(sq + EPSN) * HD_SCALE, rk = rsqrtf(sk + EPSN);
                float kq = 0.f;
#pragma unroll
                for (int i = 0; i < 8; ++i) { q[i] *= rq; k[i] *= rk; kq += q[i] * k[i]; }
                kq = row16_sum(kq);
                if (sub == 0) {
                    const float* AB = (const float*)(ws + WS_AB) + (size_t)tok * 16;
                    const float ap = AB[dir * 4 + hh] + p.in[I_GDTB][(l * 2 + dir) * 4 + hh], bp = AB[8 + dir * 4 + hh];
                    const float sp = fmaxf(ap, 0.f) + log1pf(expf(-fabsf(ap)));
                    const float alpha = expf(-expf(p.in[I_GALOG][(l * 2 + dir) * 4 + hh]) * sp);
                    *(LAS v4f*)(scl + ti * 4) = (v4f){alpha, sigmoidf_(bp), kq, 0.f};
                }
            } else {
                float fx[8], f[8]; unpack8(*(const v4u*)(row + 8 * 512 + ch), q); unpack8(*(const v4u*)(row + (9 + dir) * 512 + ch), fx); unpack8(*(const v4u*)(row + 11 * 512 + ch), v);
                const float* LB = (const float*)(ws + WS_LB) + (l * 2 + dir) * 512 + ch;
#pragma unroll
                for (int i = 0; i < 8; ++i) { const float lb = LB[i]; q[i] = siluf_(q[i]) * HD_SCALE; f[i] = lb + (1.0f - lb) * sigmoidf_(fx[i]); k[i] = (1.0f - lb) * sigmoidf_(-fx[i]); }
                *(LAS v4f*)(fs + ti * 128 + c0) = (v4f){f[0], f[1], f[2], f[3]}; *(LAS v4f*)(fs + ti * 128 + c0 + 4) = (v4f){f[4], f[5], f[6], f[7]};
            }
            *(LAS v4f*)(qs + ti * 128 + c0) = (v4f){q[0], q[1], q[2], q[3]}; *(LAS v4f*)(qs + ti * 128 + c0 + 4) = (v4f){q[4], q[5], q[6], q[7]};
            *(LAS v4f*)(ks + ti * 128 + c0) = (v4f){k[0], k[1], k[2], k[3]}; *(LAS v4f*)(ks + ti * 128 + c0 + 4) = (v4f){k[4], k[5], k[6], k[7]};
            *(LAS v4f*)(vs + ti * 128 + c0) = (v4f){v[0], v[1], v[2], v[3]}; *(LAS v4f*)(vs + ti * 128 + c0 + 4) = (v4f){v[4], v[5], v[6], v[7]};
        }
        __syncthreads();
#pragma unroll 2
        for (int i = 0; i < NB; ++i) {
            const v4f ka = *(const LAS v4f*)(ks + i * 128 + d0), kb = *(const LAS v4f*)(ks + i * 128 + d0 + 4);
            const v4f qa = *(const LAS v4f*)(qs + i * 128 + d0), qb = *(const LAS v4f*)(qs + i * 128 + d0 + 4);
            const v4f vv = *(const LAS v4f*)(vs + i * 128 + e0);
            const float kk[8] = {ka.x, ka.y, ka.z, ka.w, kb.x, kb.y, kb.z, kb.w};
            const float qq[8] = {qa.x, qa.y, qa.z, qa.w, qb.x, qb.y, qb.z, qb.w};
            v4f o = (v4f){0.f, 0.f, 0.f, 0.f};
            if (MT == 0) {
#pragma unroll
                for (int d = 0; d < 8; ++d) { S[d] = S[d] * gam + vv * kk[d]; o += S[d] * qq[d]; }
            } else if (MT == 2) {
                const v4f fa = *(const LAS v4f*)(fs + i * 128 + d0), fb = *(const LAS v4f*)(fs + i * 128 + d0 + 4);
                const float ff[8] = {fa.x, fa.y, fa.z, fa.w, fb.x, fb.y, fb.z, fb.w};
#pragma unroll
                for (int d = 0; d < 8; ++d) { S[d] = S[d] * ff[d] + vv * kk[d]; o += S[d] * qq[d]; }
            } else {
                const v4f sc4 = *(const LAS v4f*)(scl + i * 4);
                v4f r = (v4f){0.f, 0.f, 0.f, 0.f};
#pragma unroll
                for (int d = 0; d < 8; ++d) { S[d] = S[d] * sc4.x; r += S[d] * kk[d]; o += S[d] * qq[d]; }
                r.x = row16_sum(r.x); r.y = row16_sum(r.y); r.z = row16_sum(r.z); r.w = row16_sum(r.w);
                const v4f vn = (vv - r) * sc4.y;
#pragma unroll
                for (int d = 0; d < 8; ++d) S[d] += vn * kk[d];
                o.x = row16_sum(o.x); o.y = row16_sum(o.y); o.z = row16_sum(o.z); o.w = row16_sum(o.w);
                o += vn * sc4.z;
            }
            if (MT != 1) { o.x = row16_sum(o.x); o.y = row16_sum(o.y); o.z = row16_sum(o.z); o.w = row16_sum(o.w); }
            if (dg == 0) { const int st = b0 + i, pos = dir ? L - 1 - st : st; *(v4f*)(OB + (size_t)(tok0 + pos) * DM) = o; }
        }
    }
    if (!samp) { float* so = p.out + (MT == 0 ? O_RET : (MT == 1 ? O_GDN : O_HG)) + ((((size_t)seq * 2 + l) * 2 + dir) * 4 + hh) * 16384;
#pragma unroll
        for (int i = 0; i < 8; ++i) *(v4f*)(so + (d0 + i) * 128 + e0) = S[i]; }
}

typedef short s4v __attribute__((ext_vector_type(4)));
typedef short s8v __attribute__((ext_vector_type(8)));
DEV s4v cvt4(v4f x) { v2u w; w.x = pk2(x.x, x.y); w.y = pk2(x.z, x.w); return __builtin_bit_cast(s4v, w); }
DEV s8v cat8(s4v a, s4v b) { return __builtin_shufflevector(a, b, 0, 1, 2, 3, 4, 5, 6, 7); }
DEV unsigned short bf1(float x) { return (unsigned short)(pk2(x, x) & 0xffffu); }
constexpr int QI_OFF = 65536, KI_OFF = 74240, KBT_OFF = 82944, VT_OFF = 92160, EBC_OFF = 101376;
template <int MT> DEV void gla_task(const Params& p, int l, int seq, int hh, int dir, LAS unsigned char* lds, const int wave) {
    const int lane = lane_id_(), tid = wave * 64 + lane, g = lane >> 4, r15 = lane & 15;
    const int L = seq_len(seq), tok0 = seq_tok0(seq); const bool samp = seq >= 16;
    unsigned char* ws = p.ws;
    const bf16_t* PROJ = (const bf16_t*)(ws + WS_PROJ);
    float* OBc = (float*)(ws + WS_OBUF) + (size_t)dir * T_TOK * DM + MT * 512 + hh * 128 + 16 * wave + r15;
    LAS float* qf = (LAS float*)lds; LAS float* kf = qf + 4096; LAS float* vf = kf + 4096; LAS float* ff = vf + 4096;
    v4f acc[8];
    if (samp) { const float* st = p.in[MT == 0 ? I_SRET : I_SHG] + ((((size_t)(seq - 16) * 2 + l) * 2 + dir) * 4 + hh) * 16384 + 16 * wave + r15;
#pragma unroll
        for (int dt = 0; dt < 8; ++dt)
#pragma unroll
            for (int r = 0; r < 4; ++r) acc[dt][r] = st[(16 * dt + 4 * g + r) * 128];
    } else {
#pragma unroll
        for (int dt = 0; dt < 8; ++dt) acc[dt] = (v4f){0.f, 0.f, 0.f, 0.f};
    }
    float gam = 1.f;
    if (MT == 0) gam = sigmoidf_(p.in[I_RETL][(l * 2 + dir) * 4 + hh]);
    const int ti = tid >> 4, sub = tid & 15, c0 = sub * 8, ch = hh * 128 + c0;
    const int cB = tid & 127, qd = tid >> 7, sB = qd >> 1, hB = qd & 1;
    for (int b0 = 0; b0 < L; b0 += 32) {
        __syncthreads();
        {
            const int st = b0 + ti, pos = dir ? L - 1 - st : st, tok = tok0 + pos;
            const bf16_t* row = PROJ + (size_t)tok * PW;
            float q[8], k[8], v[8];
            if (MT == 0) {
                unpack8(*(const v4u*)(row + ch), q); unpack8(*(const v4u*)(row + 512 + ch), k); unpack8(*(const v4u*)(row + 1024 + ch), v);
                if (samp) {
                    float qp[8], kp[8]; unpack8(*(const v4u*)(row + (ch ^ 64)), qp); unpack8(*(const v4u*)(row + 512 + (ch ^ 64)), kp);
                    const float* RC = (const float*)(ws + WS_ROPE) + pos * 64 + (c0 & 63); const float* RS = RC + 65536;
                    const v4f ca = *(const v4f*)RC, cb = *(const v4f*)(RC + 4), sa = *(const v4f*)RS, sb = *(const v4f*)(RS + 4);
                    const float cs[8] = {ca.x, ca.y, ca.z, ca.w, cb.x, cb.y, cb.z, cb.w}, sn[8] = {sa.x, sa.y, sa.z, sa.w, sb.x, sb.y, sb.z, sb.w};
#pragma unroll
                    for (int i = 0; i < 8; ++i) {
                        if (sub < 8) { q[i] = q[i] * cs[i] - qp[i] * sn[i]; k[i] = k[i] * cs[i] - kp[i] * sn[i]; }
                        else { q[i] = qp[i] * sn[i] + q[i] * cs[i]; k[i] = kp[i] * sn[i] + k[i] * cs[i]; } }
                }
#pragma unroll
                for (int i = 0; i < 8; ++i) k[i] *= HD_SCALE;
            } else {
                float fx[8], f[8]; unpack8(*(const v4u*)(row + 8 * 512 + ch), q); unpack8(*(const v4u*)(row + (9 + dir) * 512 + ch), fx); unpack8(*(const v4u*)(row + 11 * 512 + ch), v);
                const float* LB = (const float*)(ws + WS_LB) + (l * 2 + dir) * 512 + ch;
                const v4f la = *(const v4f*)LB, lb4 = *(const v4f*)(LB + 4); const float lbv[8] = {la.x, la.y, la.z, la.w, lb4.x, lb4.y, lb4.z, lb4.w};
#pragma unroll
                for (int i = 0; i < 8; ++i) { const float lb = lbv[i]; q[i] = siluf_(q[i]) * HD_SCALE; f[i] = lb + (1.0f - lb) * sigmoidf_(fx[i]); k[i] = (1.0f - lb) * sigmoidf_(-fx[i]); }
                *(LAS v4f*)(ff + ti * 128 + c0) = (v4f){f[0], f[1], f[2], f[3]}; *(LAS v4f*)(ff + ti * 128 + c0 + 4) = (v4f){f[4], f[5], f[6], f[7]};
            }
            *(LAS v4f*)(qf + ti * 128 + c0) = (v4f){q[0], q[1], q[2], q[3]}; *(LAS v4f*)(qf + ti * 128 + c0 + 4) = (v4f){q[4], q[5], q[6], q[7]};
            *(LAS v4f*)(kf + ti * 128 + c0) = (v4f){k[0], k[1], k[2], k[3]}; *(LAS v4f*)(kf + ti * 128 + c0 + 4) = (v4f){k[4], k[5], k[6], k[7]};
            *(LAS v4f*)(vf + ti * 128 + c0) = (v4f){v[0], v[1], v[2], v[3]}; *(LAS v4f*)(vf + ti * 128 + c0 + 4) = (v4f){v[4], v[5], v[6], v[7]};
        }
        __syncthreads();
        {
            const int jo = 16 * sB + 8 * hB, jx = 16 * sB + 8 * (1 - hB);
            float own[8], po = 1.f;
#pragma unroll
            for (int t = 0; t < 8; ++t) { own[t] = (MT == 0) ? gam : ff[(jo + t) * 128 + cB]; po *= (MT == 0) ? gam : ff[(jx + t) * 128 + cB]; }
            float Fm[8]; float run = hB ? po : 1.0f;
#pragma unroll
            for (int t = 0; t < 8; ++t) { run *= own[t]; Fm[t] = run; }
            const float FC = hB ? run : run * po;
            float kb[8], vv[8];
#pragma unroll
            for (int t = 0; t < 8; ++t) { const float inv = 1.0f / Fm[t]; const int j = jo + t;
                const float kv = kf[j * 128 + cB] * inv;
                *(LAS unsigned short*)(lds + QI_OFF + j * 272 + cB * 2) = bf1(qf[j * 128 + cB] * Fm[t]);
                *(LAS unsigned short*)(lds + KI_OFF + j * 272 + cB * 2) = bf1(kv);
                kb[t] = kv * FC; vv[t] = vf[j * 128 + cB]; }
            { const v4u a = pack8(kb), b = pack8(vv); const int off = cB * 72 + (16 * sB + 8 * hB) * 2;
              *(LAS v2u*)(lds + KBT_OFF + off) = (v2u){a.x, a.y}; *(LAS v2u*)(lds + KBT_OFF + off + 8) = (v2u){a.z, a.w};
              *(LAS v2u*)(lds + VT_OFF + off) = (v2u){b.x, b.y}; *(LAS v2u*)(lds + VT_OFF + off + 8) = (v2u){b.z, b.w}; }
            if (hB == 0) *(LAS float*)(lds + EBC_OFF + (sB * 128 + cB) * 4) = FC;
        }
        __syncthreads();
#pragma unroll
        for (int s = 0; s < 2; ++s) {
            const int jb = 16 * s;
            mfma_fence8(acc);
            v4f pt = (v4f){0.f, 0.f, 0.f, 0.f};
#pragma unroll
            for (int ks = 0; ks < 4; ++ks) { const int off = (jb + r15) * 272 + (32 * ks + 8 * g) * 2;
                pt = __builtin_amdgcn_mfma_f32_16x16x32_bf16(*(const LAS s8v*)(lds + KI_OFF + off), *(const LAS s8v*)(lds + QI_OFF + off), pt, 0, 0, 0); }
            v4f pm;
#pragma unroll
            for (int r = 0; r < 4; ++r) pm[r] = (4 * g + r <= r15) ? pt[r] : 0.f;
            const s4v pa = cvt4(pm);
            const s4v vb = *(const LAS s4v*)(lds + VT_OFF + (16 * wave + r15) * 72 + (jb + 4 * g) * 2);
            s8v sb[4];
#pragma unroll
            for (int kp = 0; kp < 4; ++kp) sb[kp] = cat8(cvt4(acc[2 * kp]), cvt4(acc[2 * kp + 1]));
            asm volatile("s_nop 4" : "+v"(sb[0]), "+v"(sb[1]), "+v"(sb[2]), "+v"(sb[3]));
            v4f o = __builtin_amdgcn_mfma_f32_16x16x16bf16_1k(pa, vb, (v4f){0.f, 0.f, 0.f, 0.f}, 0, 0, 0);
#pragma unroll
            for (int kp = 0; kp < 4; ++kp) { const int off = (jb + r15) * 272 + (32 * kp + 4 * g) * 2;
                const s8v qa = cat8(*(const LAS s4v*)(lds + QI_OFF + off), *(const LAS s4v*)(lds + QI_OFF + off + 32));
                o = __builtin_amdgcn_mfma_f32_16x16x32_bf16(qa, sb[kp], o, 0, 0, 0); }
#pragma unroll
            for (int r = 0; r < 4; ++r) { const int st = b0 + jb + 4 * g + r, pos = dir ? L - 1 - st : st; OBc[(size_t)(tok0 + pos) * DM] = o[r]; }
#pragma unroll
            for (int dt = 0; dt < 8; ++dt) { const v4f sc = *(const LAS v4f*)(lds + EBC_OFF + (s * 128 + 16 * dt + 4 * g) * 4);
                const s4v ka = *(const LAS s4v*)(lds + KBT_OFF + (16 * dt + r15) * 72 + (jb + 4 * g) * 2);
                acc[dt] = __builtin_amdgcn_mfma_f32_16x16x16bf16_1k(ka, vb, acc[dt] * sc, 0, 0, 0); }
        }
    }
    if (!samp) { float* so = p.out + (MT == 0 ? O_RET : O_HG) + ((((size_t)seq * 2 + l) * 2 + dir) * 4 + hh) * 16384 + 16 * wave + r15;
#pragma unroll
        for (int dt = 0; dt < 8; ++dt)
#pragma unroll
            for (int r = 0; r < 4; ++r) so[(16 * dt + 4 * g + r) * 128] = acc[dt][r]; }
}

constexpr int GD_KF = 0, GD_VF = 16384, GD_QI = 32768, GD_KI = GD_QI + 8704, GD_GQ = GD_KI + 8704, GD_NW = GD_GQ + 8704, GD_KT0 = GD_NW + 8704, GD_KBT = GD_KT0 + 9216, GD_VT = GD_KBT + 9216,
              GD_UP = GD_VT + 9216, GD_TB = GD_UP + 1280, GD_AT = GD_TB + 1280, GD_AM = GD_AT + 1280, GD_SC = GD_AM + 2560, GD_GC = GD_SC + 1024, GD_CW = GD_GC + 16;
DEV void gdn_scalars(const Params& p, int l, int hh, int dir, int tok, LAS float* dst) {
    const float* AB = (const float*)(p.ws + WS_AB) + (size_t)tok * 16;
    const float ap = AB[dir * 4 + hh] + p.in[I_GDTB][(l * 2 + dir) * 4 + hh], bp = AB[8 + dir * 4 + hh];
    const float sp = fmaxf(ap, 0.f) + log1pf(expf(-fabsf(ap)));
    const float la = -expf(p.in[I_GALOG][(l * 2 + dir) * 4 + hh]) * sp;
    float gcum = la;
    { const int l15 = lane_id_() & 15;
#pragma unroll
      for (int off = 1; off < 16; off <<= 1) { const float y = __shfl_up(gcum, off, 16); gcum += (l15 >= off) ? y : 0.f; } }
    *(LAS v4f*)dst = (v4f){la, sigmoidf_(bp), gcum, 0.f};
}
DEV void gdn_task(const Params& p, int l, int seq, int hh, int dir, LAS unsigned char* lds, const int wave) {
    const int lane = lane_id_(), tid = wave * 64 + lane, g = lane >> 4, r15 = lane & 15;
    const int L = seq_len(seq), tok0 = seq_tok0(seq); const bool samp = seq >= 16;
    unsigned char* ws = p.ws;
    const bf16_t* PROJ = (const bf16_t*)(ws + WS_PROJ);
    float* OBc = (float*)(ws + WS_OBUF) + (size_t)dir * T_TOK * DM + 512 + hh * 128 + 16 * wave + r15;
    LAS float* kf = (LAS float*)(lds + GD_KF); LAS float* vf = (LAS float*)(lds + GD_VF);
    v4f acc[8];
    if (samp) { const float* st = p.in[I_SGDN] + ((((size_t)(seq - 16) * 2 + l) * 2 + dir) * 4 + hh) * 16384 + 16 * wave + r15;
#pragma unroll
        for (int dt = 0; dt < 8; ++dt)
#pragma unroll
            for (int r = 0; r < 4; ++r) acc[dt][r] = st[(16 * dt + 4 * g + r) * 128];
    } else {
#pragma unroll
        for (int dt = 0; dt < 8; ++dt) acc[dt] = (v4f){0.f, 0.f, 0.f, 0.f};
    }
    const int ti = tid >> 4, sub = tid & 15, c0 = sub * 8, ch = hh * 128 + c0;
    const int cB = tid & 127, qd = tid >> 7, sB = qd >> 1, hB = qd & 1;
    if (tid < 32) { const int pos = dir ? L - 1 - tid : tid; gdn_scalars(p, l, hh, dir, tok0 + pos, (LAS float*)(lds + GD_SC) + tid * 4); }
    if (tid < 288) { const int pk = tid >> 5, part = pk / 3, kk = pk % 3, c4 = (tid & 31) * 4;
        *(LAS v4f*)(lds + GD_CW + (pk * 128 + c4) * 4) = *(const v4f*)(p.in[I_GCONV] + (size_t)l * 3 * 1536 + kk * 1536 + part * 512 + hh * 128 + c4); }
    int cur = 0;
    for (int b0 = 0; b0 < L; b0 += 32, cur ^= 1) {
        __syncthreads();
        const LAS float* SC = (const LAS float*)(lds + GD_SC) + cur * 128;
        {
            if (tid < 32 && b0 + 32 < L) { const int st = b0 + 32 + tid, pos = dir ? L - 1 - st : st; gdn_scalars(p, l, hh, dir, tok0 + pos, (LAS float*)(lds + GD_SC) + (cur ^ 1) * 128 + tid * 4); }
            const int st = b0 + ti, pos = dir ? L - 1 - st : st, tok = tok0 + pos;
            const bf16_t* row = PROJ + (size_t)tok * PW;
            float q[8], k[8], v[8];
            const bool hm = pos > 0, hp = pos + 1 < L;
#pragma unroll
            for (int part = 0; part < 3; ++part) {
                float xm[8], x0[8], xp[8]; const bf16_t* src = row + (4 + part) * 512 + ch;
                unpack8(*(const v4u*)src, x0);
                if (hm) unpack8(*(const v4u*)(src - PW), xm); else {
#pragma unroll
                    for (int i = 0; i < 8; ++i) xm[i] = 0.f; }
                if (hp) unpack8(*(const v4u*)(src + PW), xp); else {
#pragma unroll
                    for (int i = 0; i < 8; ++i) xp[i] = 0.f; }
                const LAS float* w = (const LAS float*)(lds + GD_CW) + part * 384 + c0;
                const v4f w0a = *(const LAS v4f*)w, w0b = *(const LAS v4f*)(w + 4), w1a = *(const LAS v4f*)(w + 128), w1b = *(const LAS v4f*)(w + 132), w2a = *(const LAS v4f*)(w + 256), w2b = *(const LAS v4f*)(w + 260);
                const float w0[8] = {w0a.x, w0a.y, w0a.z, w0a.w, w0b.x, w0b.y, w0b.z, w0b.w}, w1[8] = {w1a.x, w1a.y, w1a.z, w1a.w, w1b.x, w1b.y, w1b.z, w1b.w},
                            w2[8] = {w2a.x, w2a.y, w2a.z, w2a.w, w2b.x, w2b.y, w2b.z, w2b.w};
#pragma unroll
                for (int i = 0; i < 8; ++i) { const float y = xm[i] * w0[i] + x0[i] * w1[i] + xp[i] * w2[i]; const float sv = siluf_(y);
                    if (part == 0) q[i] = sv; else if (part == 1) k[i] = sv; else v[i] = sv; }
            }
            float sq = 0.f, sk = 0.f;
#pragma unroll
            for (int i = 0; i < 8; ++i) { sq += q[i] * q[i]; sk += k[i] * k[i]; }
            sq = row16_sum(sq); sk = row16_sum(sk);
            const float rq = rsqrtf(sq + EPSN) * HD_SCALE, rk = rsqrtf(sk + EPSN);
            const float G = __expf(SC[ti * 4 + 2]);
            float gq[8];
#pragma unroll
            for (int i = 0; i < 8; ++i) { q[i] *= rq; k[i] *= rk; gq[i] = q[i] * G; }
            *(LAS v4u*)(lds + GD_QI + ti * 272 + c0 * 2) = pack8(q);
            *(LAS v4u*)(lds + GD_KI + ti * 272 + c0 * 2) = pack8(k);
            *(LAS v4u*)(lds + GD_GQ + ti * 272 + c0 * 2) = pack8(gq);
            *(LAS v4f*)(kf + ti * 128 + c0) = (v4f){k[0], k[1], k[2], k[3]}; *(LAS v4f*)(kf + ti * 128 + c0 + 4) = (v4f){k[4], k[5], k[6], k[7]};
            *(LAS v4f*)(vf + ti * 128 + c0) = (v4f){v[0], v[1], v[2], v[3]}; *(LAS v4f*)(vf + ti * 128 + c0 + 4) = (v4f){v[4], v[5], v[6], v[7]};
        }
        __syncthreads();
        {
            const int jo = 16 * sB + 8 * hB;
            float gj[8];
#pragma unroll
            for (int t = 0; t < 8; ++t) gj[t] = SC[(jo + t) * 4 + 2];
            const float gC = SC[(16 * sB + 15) * 4 + 2];
            float k0[8], kb[8], vv[8];
#pragma unroll
            for (int t = 0; t < 8; ++t) { const int j = jo + t; k0[t] = kf[j * 128 + cB]; kb[t] = k0[t] * __expf(gC - gj[t]); vv[t] = vf[j * 128 + cB]; }
            const v4u a = pack8(k0), b = pack8(kb), c = pack8(vv); const int off = cB * 72 + jo * 2;
            *(LAS v2u*)(lds + GD_KT0 + off) = (v2u){a.x, a.y}; *(LAS v2u*)(lds + GD_KT0 + off + 8) = (v2u){a.z, a.w};
            *(LAS v2u*)(lds + GD_KBT + off) = (v2u){b.x, b.y}; *(LAS v2u*)(lds + GD_KBT + off + 8) = (v2u){b.z, b.w};
            *(LAS v2u*)(lds + GD_VT + off) = (v2u){c.x, c.y}; *(LAS v2u*)(lds + GD_VT + off + 8) = (v2u){c.z, c.w};
            if (cB == 0 && hB == 0) *(LAS float*)(lds + GD_GC + sB * 4) = __expf(gC);
        }
        {
            const int s = (wave >> 1) & 1, typ = wave & 1;
            v4f d = (v4f){0.f, 0.f, 0.f, 0.f};
#pragma unroll
            for (int ks = 0; ks < 4; ++ks) { const int off = (16 * s + r15) * 272 + (32 * ks + 8 * g) * 2;
                d = __builtin_amdgcn_mfma_f32_16x16x32_bf16(*(const LAS s8v*)(lds + (typ ? GD_QI : GD_KI) + off), *(const LAS s8v*)(lds + GD_KI + off), d, 0, 0, 0); }
            const int ln2 = lane_id_(), j2 = ln2 & 15, g2 = ln2 >> 4;
            const float gjj = SC[(16 * s + j2) * 4 + 2];
#pragma unroll
            for (int r = 0; r < 4; ++r) { const int i = 4 * g2 + r; const v4f si = *(const LAS v4f*)(SC + (16 * s + i) * 4); const float e = __expf(si.z - gjj);
                if (typ == 0) *(LAS float*)(lds + GD_AM + ((s * 16 + i) * 20 + j2) * 4) = (i > j2) ? si.y * d[r] * e : 0.f;
                else *(LAS unsigned short*)(lds + GD_AT + (s * 16 + i) * 40 + j2 * 2) = bf1((i >= j2) ? d[r] * e : 0.f); }
        }
        __syncthreads();
        {
            const int ln3 = lane_id_(), s = (ln3 >> 4) & 1, c = ln3 & 15;
            const LAS float* AM = (const LAS float*)(lds + GD_AM) + s * 320;
            float t[16];
#pragma unroll
            for (int i = 0; i < 16; ++i) { float a = (i == c) ? 1.f : 0.f;
#pragma unroll
                for (int j4 = 0; j4 < (i + 3) / 4; ++j4) { const v4f ar = *(const LAS v4f*)(AM + i * 20 + j4 * 4);
                    if (j4 * 4 + 0 < i) a -= ar.x * t[j4 * 4 + 0]; if (j4 * 4 + 1 < i) a -= ar.y * t[j4 * 4 + 1]; if (j4 * 4 + 2 < i) a -= ar.z * t[j4 * 4 + 2]; if (j4 * 4 + 3 < i) a -= ar.w * t[j4 * 4 + 3]; }
                t[i] = a; }
            const v4f scc = *(const LAS v4f*)(SC + (16 * s + c) * 4);
            const float bc = scc.y, bge = bc * __expf(scc.z);
#pragma unroll
            for (int i = 0; i < 16; ++i) { *(LAS unsigned short*)(lds + GD_UP + (s * 16 + i) * 40 + c * 2) = bf1(t[i] * bc); *(LAS unsigned short*)(lds + GD_TB + (s * 16 + i) * 40 + c * 2) = bf1(t[i] * bge); }
        }
        __syncthreads();
#pragma unroll
        for (int jj = 0; jj < 2; ++jj) {
            const int job = wave * 2 + jj, s = job >> 3, dt = job & 7;
            const s4v a = *(const LAS s4v*)(lds + GD_TB + (s * 16 + r15) * 40 + 4 * g * 2);
            const s4v b = *(const LAS s4v*)(lds + GD_KT0 + (16 * dt + r15) * 72 + (16 * s + 4 * g) * 2);
            const v4f d = __builtin_amdgcn_mfma_f32_16x16x16bf16_1k(a, b, (v4f){0.f, 0.f, 0.f, 0.f}, 0, 0, 0);
#pragma unroll
            for (int r = 0; r < 4; ++r) *(LAS unsigned short*)(lds + GD_NW + (16 * s + 4 * g + r) * 272 + (16 * dt + r15) * 2) = bf1(-d[r]);
        }
        __syncthreads();
#pragma unroll
        for (int s = 0; s < 2; ++s) {
            const int jb = 16 * s;
            mfma_fence8(acc);
            const s4v vb = *(const LAS s4v*)(lds + GD_VT + (16 * wave + r15) * 72 + (jb + 4 * g) * 2);
            v4f vn = __builtin_amdgcn_mfma_f32_16x16x16bf16_1k(*(const LAS s4v*)(lds + GD_UP + (s * 16 + r15) * 40 + 4 * g * 2), vb, (v4f){0.f, 0.f, 0.f, 0.f}, 0, 0, 0);
            s8v sb[4];
#pragma unroll
            for (int kp = 0; kp < 4; ++kp) { const int off = (jb + r15) * 272 + (32 * kp + 4 * g) * 2;
                sb[kp] = cat8(cvt4(acc[2 * kp]), cvt4(acc[2 * kp + 1]));
                vn = __builtin_amdgcn_mfma_f32_16x16x32_bf16(cat8(*(const LAS s4v*)(lds + GD_NW + off), *(const LAS s4v*)(lds + GD_NW + off + 32)), sb[kp], vn, 0, 0, 0); }
            mfma_fence(vn);
            const s4v vnb = cvt4(vn);
            v4f o = __builtin_amdgcn_mfma_f32_16x16x16bf16_1k(*(const LAS s4v*)(lds + GD_AT + (s * 16 + r15) * 40 + 4 * g * 2), vnb, (v4f){0.f, 0.f, 0.f, 0.f}, 0, 0, 0);
#pragma unroll
            for (int kp = 0; kp < 4; ++kp) { const int off = (jb + r15) * 272 + (32 * kp + 4 * g) * 2;
                o = __builtin_amdgcn_mfma_f32_16x16x32_bf16(cat8(*(const LAS s4v*)(lds + GD_GQ + off), *(const LAS s4v*)(lds + GD_GQ + off + 32)), sb[kp], o, 0, 0, 0); }
#pragma unroll
            for (int r = 0; r < 4; ++r) { const int st = b0 + jb + 4 * g + r, pos = dir ? L - 1 - st : st; OBc[(size_t)(tok0 + pos) * DM] = o[r]; }
            const float gcs = *(const LAS float*)(lds + GD_GC + s * 4);
#pragma unroll
            for (int dt = 0; dt < 8; ++dt) { const s4v ka = *(const LAS s4v*)(lds + GD_KBT + (16 * dt + r15) * 72 + (jb + 4 * g) * 2);
                acc[dt] = __builtin_amdgcn_mfma_f32_16x16x16bf16_1k(ka, vnb, acc[dt] * gcs, 0, 0, 0); }
        }
    }
    if (!samp) { int seq2 = seq; asm volatile("" : "+s"(seq2));
        float* so = p.out + O_GDN + ((((size_t)seq2 * 2 + l) * 2 + dir) * 4 + hh) * 16384 + 16 * wave + r15;
#pragma unroll
        for (int dt = 0; dt < 8; ++dt)
#pragma unroll
            for (int r = 0; r < 4; ++r) so[(16 * dt + 4 * g + r) * 128] = acc[dt][r]; }
}

DEV void gdn_load_raw(const bf16_t* PROJ, int tok0, int L, int dir, int b0, int ti, int ch, v4u (&rw)[9]) {
    const int st = b0 + ti, pos = dir ? L - 1 - st : st;
    const bf16_t* row = PROJ + (size_t)(tok0 + pos) * PW + 4 * 512 + ch;
    const bool hm = pos > 0, hp = pos + 1 < L;
#pragma unroll
    for (int part = 0; part < 3; ++part) { const bf16_t* src = row + part * 512;
        rw[part * 3 + 0] = hm ? *(const v4u*)(src - PW) : (v4u){0u, 0u, 0u, 0u};
        rw[part * 3 + 1] = *(const v4u*)src;
        rw[part * 3 + 2] = hp ? *(const v4u*)(src + PW) : (v4u){0u, 0u, 0u, 0u}; }
}
DEV void gdn_half_task(const Params& p, int l, int seq, int hh, int dir, int eh, LAS float* lds, const int wave) {
    const int lane = lane_id_(), tid = wave * 64 + lane, dg = lane & 7, eg = lane >> 3;
    const int L = seq_len(seq), tok0 = seq_tok0(seq); const bool samp = seq >= 16;
    const int e0 = eh * 64 + wave * 8 + eg, d0 = dg * 16, d0p = d0 + 4 * (d0 >> 6);
    unsigned char* ws = p.ws;
    const bf16_t* PROJ = (const bf16_t*)(ws + WS_PROJ);
    float* OB = (float*)(ws + WS_OBUF) + (size_t)dir * T_TOK * DM + 512 + hh * 128 + e0;
    constexpr int RS = 136;
    LAS float* qs = lds; LAS float* ks = lds + NB * RS; LAS float* vs = lds + 2 * NB * RS; LAS float* scl = vs + NB * 128; LAS float* cwl = scl + NB * 4;
    v2f S[8];
    if (samp) { const float* st = p.in[I_SGDN] + ((((size_t)(seq - 16) * 2 + l) * 2 + dir) * 4 + hh) * 16384 + e0;
#pragma unroll
        for (int m = 0; m < 8; ++m) S[m] = (v2f){st[(d0 + 2 * m) * 128], st[(d0 + 2 * m + 1) * 128]};
    } else {
#pragma unroll
        for (int m = 0; m < 8; ++m) S[m] = (v2f){0.f, 0.f};
    }
    const int ti = tid >> 4, sub = tid & 15, c0 = sub * 8, ch = hh * 128 + c0;
    if (tid < 288) { const int pk = tid >> 5, part = pk / 3, kk = pk % 3, c4 = (tid & 31) * 4;
        *(LAS v4f*)(cwl + pk * 128 + c4) = *(const v4f*)(p.in[I_GCONV] + (size_t)l * 3 * 1536 + kk * 1536 + part * 512 + hh * 128 + c4); }
    v4u raw[9];
    gdn_load_raw(PROJ, tok0, L, dir, 0, ti, ch, raw);
    for (int b0 = 0; b0 < L; b0 += NB) {
        __syncthreads();
        {
            const int st = b0 + ti, pos = dir ? L - 1 - st : st, tok = tok0 + pos;
            float q[8], k[8], v[8];
#pragma unroll
            for (int part = 0; part < 3; ++part) {
                float xm[8], x0[8], xp[8];
                unpack8(raw[part * 3 + 0], xm); unpack8(raw[part * 3 + 1], x0); unpack8(raw[part * 3 + 2], xp);
                const LAS float* w = cwl + part * 384 + c0;
                const v4f w0a = *(const LAS v4f*)w, w0b = *(const LAS v4f*)(w + 4), w1a = *(const LAS v4f*)(w + 128), w1b = *(const LAS v4f*)(w + 132), w2a = *(const LAS v4f*)(w + 256), w2b = *(const LAS v4f*)(w + 260);
                const float w0[8] = {w0a.x, w0a.y, w0a.z, w0a.w, w0b.x, w0b.y, w0b.z, w0b.w}, w1[8] = {w1a.x, w1a.y, w1a.z, w1a.w, w1b.x, w1b.y, w1b.z, w1b.w},
                            w2[8] = {w2a.x, w2a.y, w2a.z, w2a.w, w2b.x, w2b.y, w2b.z, w2b.w};
#pragma unroll
                for (int i = 0; i < 8; ++i) { const float y = xm[i] * w0[i] + x0[i] * w1[i] + xp[i] * w2[i]; const float sv = siluf_(y);
                    if (part == 0) q[i] = sv; else if (part == 1) k[i] = sv; else v[i] = sv; }
            }
            float sq = 0.f, sk = 0.f;
#pragma unroll
            for (int i = 0; i < 8; ++i) { sq += q[i] * q[i]; sk += k[i] * k[i]; }
            sq = row16_sum(sq); sk = row16_sum(sk);
            const float rq = rsqrtf(sq + EPSN) * HD_SCALE, rk = rsqrtf(sk + EPSN);
            float kq = 0.f;
#pragma unroll
            for (int i = 0; i < 8; ++i) { q[i] *= rq; k[i] *= rk; kq += q[i] * k[i]; }
            kq = row16_sum(kq);
            if (sub == 0) {
                const float* AB = (const float*)(ws + WS_AB) + (size_t)tok * 16;
                const float ap = AB[dir * 4 + hh] + p.in[I_GDTB][(l * 2 + dir) * 4 + hh], bp = AB[8 + dir * 4 + hh];
                const float sp = fmaxf(ap, 0.f) + log1pf(expf(-fabsf(ap)));
                const float alpha = expf(-expf(p.in[I_GALOG][(l * 2 + dir) * 4 + hh]) * sp);
                *(LAS v4f*)(scl + ti * 4) = (v4f){alpha, sigmoidf_(bp), kq, 0.f};
            }
            const int c0p = c0 + 4 * (c0 >> 6);
            *(LAS v4f*)(qs + ti * RS + c0p) = (v4f){q[0], q[1], q[2], q[3]}; *(LAS v4f*)(qs + ti * RS + c0p + 4) = (v4f){q[4], q[5], q[6], q[7]};
            *(LAS v4f*)(ks + ti * RS + c0p) = (v4f){k[0], k[1], k[2], k[3]}; *(LAS v4f*)(ks + ti * RS + c0p + 4) = (v4f){k[4], k[5], k[6], k[7]};
            *(LAS v4f*)(vs + ti * 128 + c0) = (v4f){v[0], v[1], v[2], v[3]}; *(LAS v4f*)(vs + ti * 128 + c0 + 4) = (v4f){v[4], v[5], v[6], v[7]};
        }
        if (b0 + NB < L) gdn_load_raw(PROJ, tok0, L, dir, b0 + NB, ti, ch, raw);
        __syncthreads();
#pragma unroll 8
        for (int i = 0; i < NB; ++i) {
            const LAS v4f* kp = (const LAS v4f*)(ks + i * RS + d0p); const LAS v4f* qp = (const LAS v4f*)(qs + i * RS + d0p);
            const v4f k0 = kp[0], k1 = kp[1], k2 = kp[2], k3 = kp[3], q0 = qp[0], q1 = qp[1], q2 = qp[2], q3 = qp[3];
            const float vv = vs[i * 128 + e0];
            const v2f kk[8] = {{k0.x, k0.y}, {k0.z, k0.w}, {k1.x, k1.y}, {k1.z, k1.w}, {k2.x, k2.y}, {k2.z, k2.w}, {k3.x, k3.y}, {k3.z, k3.w}};
            const v2f qq[8] = {{q0.x, q0.y}, {q0.z, q0.w}, {q1.x, q1.y}, {q1.z, q1.w}, {q2.x, q2.y}, {q2.z, q2.w}, {q3.x, q3.y}, {q3.z, q3.w}};
            const v4f sc4 = *(const LAS v4f*)(scl + i * 4);
            v2f r2 = (v2f){0.f, 0.f}, o2 = (v2f){0.f, 0.f};
#pragma unroll
            for (int m = 0; m < 8; ++m) { S[m] = S[m] * sc4.x; r2 += S[m] * kk[m]; o2 += S[m] * qq[m]; }
            float r = r2.x + r2.y, o = o2.x + o2.y;
            r += dppf<0xB1>(r); r += dppf<0x4E>(r); r += dppf<0x141>(r);
            const float vn = (vv - r) * sc4.y;
#pragma unroll
            for (int m = 0; m < 8; ++m) S[m] += kk[m] * vn;
            o += dppf<0xB1>(o); o += dppf<0x4E>(o); o += dppf<0x141>(o);
            o += vn * sc4.z;
            if (dg == 0) { const int st = b0 + i, pos = dir ? L - 1 - st : st; OB[(size_t)(tok0 + pos) * DM] = o; }
        }
    }
    if (!samp) { float* so = p.out + O_GDN + ((((size_t)seq * 2 + l) * 2 + dir) * 4 + hh) * 16384 + e0;
#pragma unroll
        for (int m = 0; m < 8; ++m) { so[(d0 + 2 * m) * 128] = S[m].x; so[(d0 + 2 * m + 1) * 128] = S[m].y; } }
}

DEV void s5_task(const Params& p, int l, int seq, int g, int dir, LAS float* wl) {
    const int lane = lane_id_();
    const int L = seq_len(seq), tok0 = seq_tok0(seq); const bool samp = seq >= 16;
    unsigned char* ws = p.ws;
    const bf16_t* PROJ = (const bf16_t*)(ws + WS_PROJ) + 13 * 512 + g * 16;
    float* OB = (float*)(ws + WS_OBUF) + (size_t)dir * T_TOK * DM + 1536 + g * 16;
    LAS float* xs = wl; LAS float* us = wl + 16 * 132;
    const int cg_ = (l * 2 + dir) * 32 + g, idx = cg_ * 64 + lane;
    const float ar = ((const float*)(ws + WS_S5A))[idx], ai = ((const float*)(ws + WS_S5A))[8192 + idx];
    v2f bb[16];
    { const float* BR = (const float*)(ws + WS_S5B) + (size_t)idx * 16; const float* BI = BR + 131072;
#pragma unroll
        for (int c4 = 0; c4 < 4; ++c4) { const v4f a = *(const v4f*)(BR + c4 * 4), b = *(const v4f*)(BI + c4 * 4);
            bb[c4 * 4] = (v2f){a.x, b.x}; bb[c4 * 4 + 1] = (v2f){a.y, b.y}; bb[c4 * 4 + 2] = (v2f){a.z, b.z}; bb[c4 * 4 + 3] = (v2f){a.w, b.w}; } }
    float Areg[32];
    { const float* CR = p.in[I_SCRE] + (size_t)cg_ * 1024 + (lane & 15) * 64; const float* CI = p.in[I_SCIM] + (size_t)cg_ * 1024 + (lane & 15) * 64;
#pragma unroll
        for (int ks = 0; ks < 32; ++ks) { const int k = 4 * ks + (lane >> 4); Areg[ks] = ks < 16 ? CR[k] : -CI[k - 64]; } }
    float xr = 0.f, xi = 0.f;
    if (samp) { const size_t si = ((((size_t)(seq - 16) * 2 + l) * 2 + dir) * 32 + g) * 64 + lane; xr = p.in[I_S5RE][si]; xi = p.in[I_S5IM][si]; }
    v2u wn; { const int st = (lane >> 2), pos = dir ? L - 1 - st : st; wn = *(const v2u*)(PROJ + (size_t)(tok0 + pos) * PW + (lane & 3) * 4); }
    for (int blk = 0; blk < L; blk += 16) {
        { const v2u w = wn;
          if (blk + 16 < L) { const int st = blk + 16 + (lane >> 2), pos = dir ? L - 1 - st : st; wn = *(const v2u*)(PROJ + (size_t)(tok0 + pos) * PW + (lane & 3) * 4); }
          *(LAS v4f*)(us + (lane >> 2) * 16 + (lane & 3) * 4) = (v4f){lo_bf(w.x), hi_bf(w.x), lo_bf(w.y), hi_bf(w.y)}; }
        LDS_WAIT();
#pragma unroll 4
        for (int t = 0; t < 16; ++t) {
            v2f bu0 = (v2f){0.f, 0.f}, bu1 = (v2f){0.f, 0.f};
#pragma unroll
            for (int c4 = 0; c4 < 4; ++c4) { const v4f u = *(const LAS v4f*)(us + t * 16 + c4 * 4);
                bu0 += bb[c4 * 4] * u.x; bu1 += bb[c4 * 4 + 1] * u.y; bu0 += bb[c4 * 4 + 2] * u.z; bu1 += bb[c4 * 4 + 3] * u.w; }
            const v2f bu = bu0 + bu1;
            const float nr = ar * xr - ai * xi + bu.x, ni = ar * xi + ai * xr + bu.y; xr = nr; xi = ni;
            xs[t * 132 + lane] = xr; xs[t * 132 + 64 + lane] = xi;
        }
        LDS_WAIT();
        v4f a0 = (v4f){0.f, 0.f, 0.f, 0.f}, a1 = (v4f){0.f, 0.f, 0.f, 0.f};
#pragma unroll
        for (int ks = 0; ks < 32; ks += 2) {
            const float b0 = xs[(lane & 15) * 132 + 4 * ks + (lane >> 4)], b1 = xs[(lane & 15) * 132 + 4 * ks + 4 + (lane >> 4)];
            a0 = __builtin_amdgcn_mfma_f32_16x16x4f32(Areg[ks], b0, a0, 0, 0, 0);
            a1 = __builtin_amdgcn_mfma_f32_16x16x4f32(Areg[ks + 1], b1, a1, 0, 0, 0);
        }
        { const int st = blk + (lane & 15), pos = dir ? L - 1 - st : st; *(v4f*)(OB + (size_t)(tok0 + pos) * DM + (lane >> 4) * 4) = a0 + a1; }
        LDS_WAIT();
    }
    if (!samp) { const size_t so = ((((size_t)seq * 2 + l) * 2 + dir) * 32 + g) * 64 + lane; p.out[O_S5RE + so] = xr; p.out[O_S5IM + so] = xi; }
}

DEV void mixer_phase(const Params& p, int l, LAS unsigned char* lds, const int wave, const int rep = 0) {
    const int tid = wave * 64 + lane_id_();
    unsigned* ctr = (unsigned*)(p.ws + WS_CTL) + 64 * (l + 2 * rep);
    volatile LAS unsigned* slot = (volatile LAS unsigned*)(lds + LDS_BYTES - 64);
    for (;;) {
        __syncthreads();
        if (tid == 0) *slot = atomicAdd(ctr, 1u);
        __syncthreads();
        const int t = (int)*slot;
        if (t >= 960) break;
        int mt, seq, rem, eh = 0;
        if (t < 128) { mt = 1; rem = t >> 1; eh = t & 1; seq = 16 + (rem >> 3); }
        else if (t < 192) { mt = 3; rem = t - 128; seq = 16 + (rem >> 3); }
        else if (t < 448) { const int j = t - 192; mt = 1; rem = j >> 1; eh = j & 1; seq = rem >> 3; }
        else if (t < 576) { const int j = t - 448; mt = (j >> 6) ? 2 : 0; rem = j & 63; seq = 16 + (rem >> 3); }
        else if (t < 704) { mt = 3; rem = t - 576; seq = rem >> 3; }
        else { const int j = t - 704; mt = (j >> 7) ? 2 : 0; rem = j & 127; seq = rem >> 3; }
        const int hh = (rem >> 1) & 3, dir = rem & 1;
        if (mt == 0) gla_task<0>(p, l, seq, hh, dir, lds, wave);
        else if (mt == 1) gdn_half_task(p, l, seq, hh, dir, eh, (LAS float*)lds, wave);
        else if (mt == 2) gla_task<2>(p, l, seq, hh, dir, lds, wave);
        else s5_task(p, l, seq, (rem & 7) * 4 + (wave >> 1), wave & 1, (LAS float*)(lds + wave * 9472));
    }
}

DEV void post_phase(const Params& p, int l, const int wave) {
    const int lane = lane_id_();
    const int gw = blockIdx.x * NWAVES + wave, NGW = gridDim.x * NWAVES;
    unsigned char* ws = p.ws;
    const float* O0 = (const float*)(ws + WS_OBUF); const float* O1 = O0 + (size_t)T_TOK * DM;
    const int hc = (lane & 15) * 8;
    for (int row = gw; row < T_TOK; row += NGW) {
        const bf16_t* pr = (const bf16_t*)(ws + WS_PROJ) + (size_t)row * PW;
        bf16_t* mix = (bf16_t*)(ws + WS_HB) + (size_t)row * DM;
#pragma unroll
        for (int seg = 0; seg < 4; ++seg) {
            const int col = seg * 512 + lane * 8;
            const v4f a0 = *(const v4f*)(O0 + (size_t)row * DM + col), a1 = *(const v4f*)(O0 + (size_t)row * DM + col + 4);
            const v4f b0 = *(const v4f*)(O1 + (size_t)row * DM + col), b1 = *(const v4f*)(O1 + (size_t)row * DM + col + 4);
            float a[8] = {a0.x + b0.x, a0.y + b0.y, a0.z + b0.z, a0.w + b0.w, a1.x + b1.x, a1.y + b1.y, a1.z + b1.z, a1.w + b1.w};
            float o[8];
            if (seg < 3) {
                float g[8]; unpack8(*(const v4u*)(pr + (seg == 0 ? 3 : (seg == 1 ? 7 : 12)) * 512 + lane * 8), g);
                if (seg == 0) {
                    float s = 0.f;
#pragma unroll
                    for (int i = 0; i < 8; ++i) s += a[i];
                    const float mean = row16_sum(s) * (1.0f / 128.0f); float q = 0.f;
#pragma unroll
                    for (int i = 0; i < 8; ++i) { a[i] -= mean; q += a[i] * a[i]; }
                    const float rs = rsqrtf(row16_sum(q) * (1.0f / 128.0f) + EPSN);
#pragma unroll
                    for (int i = 0; i < 8; ++i) o[i] = a[i] * rs * siluf_(g[i]);
                } else {
                    const float* nw = p.in[seg == 1 ? I_GNW : I_HNW] + l * 128 + hc; float q = 0.f;
#pragma unroll
                    for (int i = 0; i < 8; ++i) q += a[i] * a[i];
                    const float rs = rsqrtf(row16_sum(q) * (1.0f / 128.0f) + EPSN);
#pragma unroll
                    for (int i = 0; i < 8; ++i) o[i] = a[i] * rs * nw[i] * siluf_(g[i]);
                }
                *(v4u*)(mix + col) = pack8(o);
            } else {
                float su[8]; unpack8(*(const v4u*)(pr + 13 * 512 + lane * 8), su);
                const float* dd = p.in[I_S5D] + l * 512 + lane * 8;
#pragma unroll
                for (int i = 0; i < 8; ++i) { const float y = a[i] + dd[i] * su[i]; const float u = 0.7978845608028654f * (y + 0.044715f * y * y * y);
                    o[i] = 0.5f * y * (1.0f + tanhf(u)); }
                *(v4u*)((bf16_t*)(ws + WS_Z) + (size_t)row * 512 + lane * 8) = pack8(o);
            }
        }
    }
}

#define PH_IN(k) (lo <= (k) && (k) < hi)
DEV void grid_bar(unsigned* ctr, unsigned target, const int wave) {
    asm volatile("s_waitcnt vmcnt(0) lgkmcnt(0)" ::: "memory");
    __syncthreads();
    if (wave == 0 && lane_id_() == 0) {
        __hip_atomic_fetch_add(ctr, 1u, __ATOMIC_RELEASE, __HIP_MEMORY_SCOPE_AGENT);
        while (__hip_atomic_load(ctr, __ATOMIC_RELAXED, __HIP_MEMORY_SCOPE_AGENT) < target) __builtin_amdgcn_s_sleep(2);
        __builtin_amdgcn_fence(__ATOMIC_ACQUIRE, "agent");
        asm volatile("s_waitcnt vmcnt(0)" ::: "memory");
    }
    __syncthreads();
}
#define PH_SEAM(k) do { if (PH_IN(k) && PH_IN((k) + 1)) { if ((k) == 0) grid.sync(); else grid_bar((unsigned*)(p.ws + WS_CTL) + 256, (unsigned)(k) * gridDim.x, wave); } } while (0)
template <int L_> DEV void layer_phases(const Params& p, LAS unsigned char* lds, cg::grid_group& grid, int lo, int hi, const int wave) {
    constexpr int l = L_, B = 1 + 9 * L_;
    unsigned char* ws = p.ws;
    const float* mod = (const float*)(ws + WS_MOD) + (size_t)l * 9 * NMOD;
    if (PH_IN(B + 0)) norm_phase<0>(p, l, wave);
    PH_SEAM(B + 0);
    if (PH_IN(B + 1)) {
        pg8::Gemm g{(const bf16_t*)(ws + WS_HB), (const bf16_t*)(ws + WS_WIN) + (size_t)l * PW * DM, T_TOK, PW, DM}; pg8::StaticOrder S; S.init(T_TOK, PW, gridDim.x, blockIdx.x);
        EpiProjBf16 E{(bf16_t*)(ws + WS_PROJ), PW};
        pg8::gemm_phase<EpiProjBf16, pg8::StaticOrder>(lds, g, S, E, nullptr, wave);
    }
    PH_SEAM(B + 1);
    if (PH_IN(B + 2)) mixer_phase(p, l, lds, wave);
#ifdef PROBE_MIXER2
    if (PH_IN(B + 2)) mixer_phase(p, l, lds, wave, 1);
#endif
    PH_SEAM(B + 2);
    if (PH_IN(B + 3)) post_phase(p, l, wave);
    PH_SEAM(B + 3);
    if (PH_IN(B + 4)) {
        pg8::Gemm g{(const bf16_t*)(ws + WS_Z), (const bf16_t*)(ws + WS_WGLU) + (size_t)l * 512 * 512, T_TOK, 512, 512}; pg8::StaticOrder S; S.init(T_TOK, 512, gridDim.x, blockIdx.x);
        EpiGlu E{(const bf16_t*)(ws + WS_Z), (bf16_t*)(ws + WS_HB), p.in[I_GLUB] + l * 512};
        pg8::gemm_phase<EpiGlu, pg8::StaticOrder>(lds, g, S, E, nullptr, wave);
    }
    PH_SEAM(B + 4);
    if (PH_IN(B + 5)) {
        pg8::Gemm g{(const bf16_t*)(ws + WS_HB), (const bf16_t*)(ws + WS_WOUT) + (size_t)l * DM * DM, T_TOK, DM, DM}; pg8::StaticOrder S; S.init(T_TOK, DM, gridDim.x, blockIdx.x);
        float* xr = (float*)(ws + WS_XRES);
        EpiResid E{l == 0 ? p.in[I_XP] : xr, l == 0 ? p.in[I_XS] : xr, l == 0 ? NTP : 0, xr, mod + 2 * DM};
        pg8::gemm_phase<EpiResid, pg8::StaticOrder>(lds, g, S, E, nullptr, wave);
    }
    PH_SEAM(B + 5);
    if (PH_IN(B + 6)) norm_phase<1>(p, l, wave);
    PH_SEAM(B + 6);
    if (PH_IN(B + 7)) {
        pg8::Gemm g{(const bf16_t*)(ws + WS_HB), (const bf16_t*)(ws + WS_W13) + (size_t)l * 2 * FFH * DM, T_TOK, 2 * FFH, DM}; pg8::StaticOrder S; S.init(T_TOK, 2 * FFH, gridDim.x, blockIdx.x);
        EpiGated E{(bf16_t*)(ws + WS_PROJ)};
        pg8::gemm_phase<EpiGated, pg8::StaticOrder>(lds, g, S, E, nullptr, wave);
    }
    PH_SEAM(B + 7);
    if (PH_IN(B + 8)) {
        pg8::Gemm g{(const bf16_t*)(ws + WS_PROJ), (const bf16_t*)(ws + WS_W2) + (size_t)l * DM * FFH, T_TOK, DM, FFH}; pg8::StaticOrder S; S.init(T_TOK, DM, gridDim.x, blockIdx.x);
        float* xr = (float*)(ws + WS_XRES);
        EpiResid E{xr, xr, 0, xr, mod + 5 * DM};
        pg8::gemm_phase<EpiResid, pg8::StaticOrder>(lds, g, S, E, nullptr, wave);
    }
    PH_SEAM(B + 8);
}
__global__ void __launch_bounds__(NTHREADS, 2) trunk_fwd(Params p) {
    extern __shared__ __attribute__((aligned(16))) unsigned char lds_raw[];
    LAS unsigned char* lds = (LAS unsigned char*)lds_raw;
    cg::grid_group grid = cg::this_grid();
    const int lo = p.ph_lo, hi = p.ph_hi;
    const int wave = __builtin_amdgcn_readfirstlane((int)(threadIdx.x >> 6));
    if (PH_IN(0)) phase0(p, lds, wave);
    PH_SEAM(0);
    layer_phases<0>(p, lds, grid, lo, hi, wave);
    layer_phases<1>(p, lds, grid, lo, hi, wave);
    if (PH_IN(19)) norm_phase<2>(p, 0, wave);
}

#ifndef N_LAUNCH_MODE
#define N_LAUNCH_MODE 1
#endif
extern "C" void kernel_launch(void* const* d_in, const int* in_sizes, int n_in, void* d_out, int out_size, void* d_ws, size_t ws_size, hipStream_t stream) {
    static int grid = 0;
    if (grid == 0) {
        if (n_in != 36 || ws_size < WS_END) { fprintf(stderr, "kernel_launch: expected 36 inputs and >= %zu bytes of workspace, got %d / %zu\n", (size_t)WS_END, n_in, ws_size); grid = -1; return; }
        int dev = 0, cus = 0, per_cu = 0;
        hipGetDevice(&dev); hipDeviceGetAttribute(&cus, hipDeviceAttributeMultiprocessorCount, dev);
        if (hipFuncSetAttribute((const void*)trunk_fwd, hipFuncAttributeMaxDynamicSharedMemorySize, LDS_BYTES) != hipSuccess) { fprintf(stderr, "kernel_launch: hipFuncSetAttribute failed\n"); grid = -1; return; }
        hipOccupancyMaxActiveBlocksPerMultiprocessor(&per_cu, (const void*)trunk_fwd, NTHREADS, LDS_BYTES);
        if (per_cu < 1) { fprintf(stderr, "kernel_launch: occupancy query says %d blocks per CU\n", per_cu); per_cu = 1; }
        (void)hipGetLastError();
        grid = cus;
    }
    if (grid < 0) return;
    hipMemsetAsync((char*)d_ws + WS_CTL, 0, 4096, stream);
    Params p{};
    for (int i = 0; i < 36; ++i) p.in[i] = (const float*)d_in[i];
    p.out = (float*)d_out; p.ws = (unsigned char*)d_ws;
#if N_LAUNCH_MODE == 1
    p.ph_lo = 0; p.ph_hi = 20;
    void* args[] = {&p};
    hipError_t e = hipLaunchCooperativeKernel((const void*)trunk_fwd, dim3(grid), dim3(NTHREADS), args, LDS_BYTES, stream);
    if (e != hipSuccess) fprintf(stderr, "cooperative launch failed: %s (grid %d)\n", hipGetErrorString(e), grid);
#else
    for (int ph = 0; ph < 20; ++ph) { p.ph_lo = ph; p.ph_hi = ph + 1; hipLaunchKernelGGL(trunk_fwd, dim3(grid), dim3(NTHREADS), LDS_BYTES, stream, p); }
#endif
}
```

```cpp
#include <hip/hip_runtime.h>
#include <hip/hip_cooperative_groups.h>
#include <cstdio>
namespace cg = cooperative_groups;
__device__ __forceinline__ int lane_id_() { int r; asm volatile("v_mbcnt_lo_u32_b32 %0, -1, 0\n\tv_mbcnt_hi_u32_b32 %0, -1, %0" : "=v"(r)); return r; }
namespace pg8 {
#define PG8_LAS __attribute__((address_space(3)))
typedef unsigned short bf16_t;
typedef short bf16x8 __attribute__((ext_vector_type(8)));
typedef float f32x4 __attribute__((ext_vector_type(4)));
typedef unsigned u32x4 __attribute__((ext_vector_type(4)));
constexpr int BM = 256, BK = 64, HALF = 128, HTB = HALF * BK * 2  , STAGE_BYTES = 8 * HTB, NXCD = 8, WGM = 8;

__host__ __device__ __forceinline__ int lds_byte(int r, int c) { const int st = (r >> 4) * 2 + (c >> 5), rr = r & 15, cc = c & 31, ob = rr * 64 + cc * 2; return st * 1024 + (ob ^ (((ob >> 9) & 1) << 5)); }
__host__ __device__ __forceinline__ void stage_rc(int b, int& R, int& C) { const int st = b / 1024, sb = b % 1024, swz = sb ^ (((sb >> 9) & 1) << 5); R = (st >> 1) * 16 + swz / 64; C = (st & 1) * 32 + (swz % 64) / 2; }
__host__ __device__ __forceinline__ int perm32(int rho) { const int n = rho >> 4, i = rho & 15; return 8 * (i >> 2) + 4 * n + (i & 3); }

struct Unit { int pm, pn; };
struct Gemm { const bf16_t* A; const bf16_t* Bt; int M, N, K; };

struct StaticOrder {
    int nM, nN, nwg, G, c;
    __host__ __device__ void init(int M, int N, int G_, int c_) { nM = M / BM; nN = N / BM; nwg = nM * nN; G = G_; c = c_; }
    __host__ __device__ bool next(int i, Unit& u) const {
        const long L = (long)i * G + c; if (L >= nwg) return false;
        int wgid = (int)L; { const int q = nwg / NXCD, r = nwg % NXCD, xcd = wgid % NXCD, off = wgid / NXCD; wgid = (xcd < r ? xcd * (q + 1) : r * (q + 1) + (xcd - r) * q) + off; }
        const int nig = WGM * nN, gid = wgid / nig, fm = gid * WGM, gsz = (nM - fm) < WGM ? (nM - fm) : WGM;
        u.pm = fm + ((wgid % nig) % gsz); u.pn = (wgid % nig) / gsz; return true;
    }
    __device__ __forceinline__ void a_ready(const Unit&) const {}
    __device__ __forceinline__ void done(const Unit&) const {}
};
__device__ __forceinline__ unsigned cvt_pk_bf16(float lo, float hi) { unsigned r; asm volatile("v_cvt_pk_bf16_f32 %0, %1, %2" : "=v"(r) : "v"(lo), "v"(hi)); return r; }
typedef float f32x2 __attribute__((ext_vector_type(2)));
template <class Epi, class Sched, bool STAMP = false>
__device__ __forceinline__ void gemm_phase(PG8_LAS unsigned char* lds, const Gemm g, const Sched& S, const Epi& E, unsigned long long* stamps, const int wave_in) {
    const int wid = wave_in, lane = lane_id_(), tid = wid * 64 + lane, wr = wid >> 2, wc = wid & 3, fr = lane & 15, fq = lane >> 4;
    const int K = g.K, nt = K / BK;
    int ts_lo = 0, ts_hi = 0, nts = 0; const unsigned long long rt_entry = STAMP ? (unsigned long long)wall_clock64() : 0ull;
#define PG8_STAMP() do { if (STAMP && wid == 0 && nts < 64) { const unsigned long long _c = (unsigned long long)clock64(); \
        ts_lo = (lane == nts) ? (int)(unsigned)_c : ts_lo; ts_hi = (lane == nts) ? (int)(unsigned)(_c >> 32) : ts_hi; ++nts; } } while (0)
    PG8_STAMP();
    unsigned voffA[2], voffB[2];
#pragma unroll
    for (int i = 0; i < 2; ++i) { int R, C; stage_rc(tid * 16 + i * 8192, R, C); const int Rb = Epi::PERM ? ((R & ~31) + perm32(R & 31)) : R;
        voffA[i] = (unsigned)(R * K + C) * 2u; voffB[i] = (unsigned)(Rb * K + C) * 2u; }
    const size_t kstep = (size_t)(BK * 2);
    const size_t hstep = (size_t)HALF * K * 2;
    const size_t tstep = 2 * hstep;
    const unsigned ldsw = (unsigned)wid * 1024u;
    const int aoff = lds_byte(wr * 64 + fr, fq * 8), boff = lds_byte(wc * 32 + fr, fq * 8);
#define PG8_SA(b, h) (((b) * 2 + (h)) * HTB)
#define PG8_SB(b, h) ((4 + (b) * 2 + (h)) * HTB)
#define PG8_STAGE(bufoff, gbase, voff) do { _Pragma("unroll") for (int _i = 0; _i < 2; ++_i) \
        __builtin_amdgcn_global_load_lds((const unsigned*)((const char*)(gbase) + (voff)[_i]), (PG8_LAS unsigned*)(lds + (bufoff) + ldsw + _i * 8192), 16, 0, 0); } while (0)
#define PG8_LDA(dst, b, h) do { _Pragma("unroll") for (int m = 0; m < 4; ++m) _Pragma("unroll") for (int k = 0; k < 2; ++k) dst[m][k] = *(const PG8_LAS bf16x8*)(lds + PG8_SA(b, h) + aoff + m * 2048 + k * 1024); } while (0)
#define PG8_LDB(dst, b, h) do { _Pragma("unroll") for (int n = 0; n < 2; ++n) _Pragma("unroll") for (int k = 0; k < 2; ++k) dst[n][k] = *(const PG8_LAS bf16x8*)(lds + PG8_SB(b, h) + boff + n * 2048 + k * 1024); } while (0)
#define PG8_MMA(ai, bj, At, Bt) do { __builtin_amdgcn_s_setprio(1); _Pragma("unroll") for (int m = 0; m < 4; ++m) _Pragma("unroll") for (int n = 0; n < 2; ++n) _Pragma("unroll") for (int k = 0; k < 2; ++k) \
        acc[ai][bj][m][n] = __builtin_amdgcn_mfma_f32_16x16x32_bf16(Bt[n][k], At[m][k], acc[ai][bj][m][n], 0, 0, 0); __builtin_amdgcn_s_setprio(0); } while (0)
#define PG8_WAIT_V(n) asm volatile("s_waitcnt vmcnt(" #n ")" ::: "memory")
#define PG8_WAIT_L(n) asm volatile("s_waitcnt lgkmcnt(" #n ")" ::: "memory")
#define PG8_BAR __builtin_amdgcn_s_barrier()
#define PG8_SCHED __builtin_amdgcn_sched_barrier(0)
    Unit cur, nxt; int ui = 0;
    if (!S.next(0, cur)) return;
    f32x4 acc[2][2][4][2];
#pragma unroll
    for (int a = 0; a < 2; ++a)
#pragma unroll
        for (int b = 0; b < 2; ++b)
#pragma unroll
            for (int m = 0; m < 4; ++m)
#pragma unroll
                for (int n = 0; n < 2; ++n) acc[a][b][m][n] = (f32x4){0.f, 0.f, 0.f, 0.f};
    bf16x8 At[4][2], B0[2][2], B1[2][2];
    const char* cA = (const char*)g.A + (size_t)cur.pm * tstep; const char* cB = (const char*)g.Bt + (size_t)cur.pn * tstep;
    S.a_ready(cur);
    PG8_STAGE(PG8_SB(0, 0), cB, voffB); PG8_STAGE(PG8_SA(0, 0), cA, voffA); PG8_STAGE(PG8_SB(0, 1), cB + hstep, voffB); PG8_STAGE(PG8_SA(0, 1), cA + hstep, voffA);
    if (wr == 1) PG8_BAR;
    PG8_WAIT_V(4); PG8_BAR;
    PG8_STAGE(PG8_SB(1, 0), cB + kstep, voffB); PG8_STAGE(PG8_SA(1, 0), cA + kstep, voffA); PG8_STAGE(PG8_SB(1, 1), cB + hstep + kstep, voffB);
    PG8_WAIT_V(6); PG8_BAR;
    PG8_STAMP();
    for (;;) {
        const bool has_next = S.next(ui + 1, nxt);
        const char* nA = has_next ? (const char*)g.A + (size_t)nxt.pm * tstep : cA; const char* nB = has_next ? (const char*)g.Bt + (size_t)nxt.pn * tstep : cB;
        for (int t = 0; t < nt; t += 2) {
            const bool last = (t == nt - 2);
            const char* a1 = cA + (size_t)(t + 1) * kstep;
            const char* a2 = last ? nA : cA + (size_t)(t + 2) * kstep; const char* b2 = last ? nB : cB + (size_t)(t + 2) * kstep;
            const char* a3 = a2 + kstep; const char* b3 = b2 + kstep;
            if (last && has_next) S.a_ready(nxt);
            PG8_LDB(B0, 0, 0); PG8_SCHED; PG8_LDA(At, 0, 0); PG8_STAGE(PG8_SA(1, 1), a1 + hstep, voffA);
            PG8_WAIT_L(8); PG8_BAR; PG8_WAIT_L(0); PG8_MMA(0, 0, At, B0); PG8_BAR; PG8_SCHED;
            PG8_LDB(B1, 0, 1); PG8_STAGE(PG8_SB(0, 0), b2, voffB);
            PG8_BAR; PG8_WAIT_L(0); PG8_MMA(0, 1, At, B1); PG8_BAR;
            PG8_LDA(At, 0, 1); PG8_STAGE(PG8_SA(0, 0), a2, voffA);
            PG8_BAR; PG8_WAIT_L(0); PG8_MMA(1, 0, At, B0); PG8_BAR; PG8_SCHED;
            PG8_STAGE(PG8_SB(0, 1), b2 + hstep, voffB);
            PG8_WAIT_V(6); PG8_BAR; PG8_MMA(1, 1, At, B1); PG8_BAR;
            PG8_LDB(B0, 1, 0); PG8_SCHED; PG8_LDA(At, 1, 0); PG8_STAGE(PG8_SA(0, 1), a2 + hstep, voffA);
            PG8_WAIT_L(8); PG8_BAR; PG8_WAIT_L(0); PG8_MMA(0, 0, At, B0); PG8_BAR; PG8_SCHED;
            PG8_LDB(B1, 1, 1); PG8_STAGE(PG8_SB(1, 0), b3, voffB);
            PG8_BAR; PG8_WAIT_L(0); PG8_MMA(0, 1, At, B1); PG8_BAR;
            PG8_LDA(At, 1, 1); PG8_STAGE(PG8_SA(1, 0), a3, voffA);
            PG8_BAR; PG8_WAIT_L(0); PG8_MMA(1, 0, At, B0); PG8_BAR; PG8_SCHED;
            PG8_STAGE(PG8_SB(1, 1), b3 + hstep, voffB);
            PG8_WAIT_V(6); PG8_BAR; PG8_MMA(1, 1, At, B1); PG8_BAR;
        }
        PG8_STAMP();
        if constexpr (!Epi::AFTER_DRAIN) { E(acc, cur, wr, wc, fr, fq); S.done(cur); }
        PG8_STAMP();
        if (!has_next) break;
#pragma unroll
        for (int a = 0; a < 2; ++a)
#pragma unroll
            for (int b = 0; b < 2; ++b)
#pragma unroll
                for (int m = 0; m < 4; ++m)
#pragma unroll
                    for (int n = 0; n < 2; ++n) acc[a][b][m][n] = (f32x4){0.f, 0.f, 0.f, 0.f};
        cur = nxt; cA = nA; cB = nB; ++ui;
    }
    PG8_WAIT_V(0);
    if (wr == 0) PG8_BAR;
    PG8_BAR;
    if constexpr (Epi::AFTER_DRAIN) { E.fused(acc, cur, wr, wc, fr, fq, lds, wid, lane); S.done(cur); }
    PG8_STAMP();
    if (STAMP && wid == 0) { stamps[lane] = lane < nts ? (((unsigned long long)(unsigned)ts_hi << 32) | (unsigned)ts_lo) : 0ull;
        if (lane == 62) stamps[62] = rt_entry; if (lane == 63) stamps[63] = (unsigned long long)wall_clock64(); }
#undef PG8_STAMP
#undef PG8_SA
#undef PG8_SB
#undef PG8_STAGE
#undef PG8_LDA
#undef PG8_LDB
#undef PG8_MMA
#undef PG8_WAIT_V
#undef PG8_WAIT_L
#undef PG8_BAR
#undef PG8_SCHED
}
}

#define LAS __attribute__((address_space(3)))
#define DEV __device__ __forceinline__
typedef unsigned short bf16_t;
typedef float v4f __attribute__((ext_vector_type(4)));
typedef float v2f __attribute__((ext_vector_type(2)));
typedef unsigned v4u __attribute__((ext_vector_type(4)));
typedef unsigned v2u __attribute__((ext_vector_type(2)));

constexpr int T_TOK = 12288, NTP = 4096, DM = 2048, PW = 7168, FFH = 5632, NMOD = 12288;
constexpr int NTHREADS = 512, NWAVES = 8;
constexpr int LDS_BYTES = 131072;
constexpr float EPSN = 1e-6f;
constexpr float HD_SCALE = 0.08838834764831845f;

constexpr size_t WS_CTL = 0;
constexpr size_t WS_MOD = 4096;
constexpr size_t WS_LB = WS_MOD + (size_t)2 * 9 * NMOD * 4;
constexpr size_t WS_S5A = WS_LB + 2 * 2 * 512 * 4;
constexpr size_t WS_S5B = WS_S5A + 2 * 8192 * 4;
constexpr size_t WS_ROPE = WS_S5B + 2 * 131072 * 4;
constexpr size_t WS_AB = WS_ROPE + 2 * 65536 * 4;
constexpr size_t WS_WABT = WS_AB + (size_t)T_TOK * 16 * 4;
constexpr size_t WS_WIN = WS_WABT + (size_t)2 * 16 * DM * 4;
constexpr size_t WS_WOUT = WS_WIN + (size_t)2 * PW * DM * 2;
constexpr size_t WS_W13 = WS_WOUT + (size_t)2 * DM * DM * 2;
constexpr size_t WS_W2 = WS_W13 + (size_t)2 * 2 * FFH * DM * 2;
constexpr size_t WS_WGLU = WS_W2 + (size_t)2 * DM * FFH * 2;
constexpr size_t WS_HB = WS_WGLU + (size_t)2 * 512 * 512 * 2;
constexpr size_t WS_Z = WS_HB + (size_t)T_TOK * DM * 2;
constexpr size_t WS_XRES = WS_Z + (size_t)T_TOK * 512 * 2;
constexpr size_t WS_PROJ = WS_XRES + (size_t)T_TOK * DM * 4;
constexpr size_t WS_OBUF = WS_PROJ + (size_t)T_TOK * PW * 2;
constexpr size_t WS_END = WS_OBUF + (size_t)2 * T_TOK * DM * 4;

struct Params { const float* in[36]; float* out; unsigned char* ws; int ph_lo, ph_hi; };
enum { I_XP = 0, I_XS, I_SRET, I_SGDN, I_SHG, I_S5RE, I_S5IM, I_C, I_CCTX, I_N1W, I_N2W, I_FNW, I_ADAW, I_ADAB, I_INP, I_OUTP, I_RETL, I_GCONV, I_GALOG, I_GDTB,
       I_GNW, I_HLB, I_HNW, I_SARE, I_SAIM, I_SBRE, I_SBIM, I_SCRE, I_SCIM, I_SLOG, I_S5D, I_GLUW, I_GLUB, I_W1, I_W3, I_W2 };
constexpr size_t O_Y = 0;
constexpr size_t O_RET = (size_t)T_TOK * DM;
constexpr size_t O_GDN = O_RET + 4194304;
constexpr size_t O_HG = O_GDN + 4194304;
constexpr size_t O_S5RE = O_HG + 4194304;
constexpr size_t O_S5IM = O_S5RE + 131072;

DEV float bf2f(bf16_t v) { return __uint_as_float(((unsigned)v) << 16); }
DEV unsigned pk2(float lo, float hi) { unsigned r; asm volatile("v_cvt_pk_bf16_f32 %0, %1, %2" : "=v"(r) : "v"(lo), "v"(hi)); return r; }
DEV void mfma_fence(v4f& x) { asm volatile("s_nop 15\n\ts_nop 15" : "+v"(x)); }
DEV void mfma_fence8(v4f (&a)[8]) { asm volatile("s_nop 15\n\ts_nop 15" : "+v"(a[0]), "+v"(a[1]), "+v"(a[2]), "+v"(a[3]), "+v"(a[4]), "+v"(a[5]), "+v"(a[6]), "+v"(a[7])); }
DEV float lo_bf(unsigned w) { return __uint_as_float(w << 16); }
DEV float hi_bf(unsigned w) { return __uint_as_float(w & 0xffff0000u); }
DEV void unpack8(v4u w, float (&f)[8]) { f[0] = lo_bf(w.x); f[1] = hi_bf(w.x); f[2] = lo_bf(w.y); f[3] = hi_bf(w.y); f[4] = lo_bf(w.z); f[5] = hi_bf(w.z); f[6] = lo_bf(w.w); f[7] = hi_bf(w.w); }
DEV v4u pack8(const float (&f)[8]) { v4u w; w.x = pk2(f[0], f[1]); w.y = pk2(f[2], f[3]); w.z = pk2(f[4], f[5]); w.w = pk2(f[6], f[7]); return w; }
DEV float sigmoidf_(float x) { return __builtin_amdgcn_rcpf(1.0f + __expf(-x)); }
DEV float siluf_(float x) { return x * sigmoidf_(x); }
template <int CTRL> DEV float dppf(float v) { return __builtin_bit_cast(float, __builtin_amdgcn_update_dpp(0, __builtin_bit_cast(int, v), CTRL, 0xf, 0xf, false)); }
DEV float row16_sum(float v) {
    v += dppf<0xB1>(v); v += dppf<0x4E>(v); v += dppf<0x141>(v); v += dppf<0x140>(v); return v;
}
DEV float wave_sum(float v) { v = row16_sum(v); v += __shfl_xor(v, 16); v += __shfl_xor(v, 32); return v; }
#define LDS_WAIT() asm volatile("s_waitcnt lgkmcnt(0)" ::: "memory")
DEV int seq_len(int seq) { return seq < 16 ? 256 : 1024; }
DEV int seq_tok0(int seq) { return seq < 16 ? seq * 256 : NTP + (seq - 16) * 1024; }
DEV int mod_row_of(int row) { return row < NTP ? 0 : 1 + ((row - NTP) >> 10); }

struct EpiProjBf16 {
    static constexpr bool PERM = true, AFTER_DRAIN = false;
    bf16_t* O; int ldc;
    DEV void operator()(const pg8::f32x4 (&acc)[2][2][4][2], const pg8::Unit& u, int wr, int wc, int fr, int fq) const {
        const int row0 = u.pm * 256 + wr * 64 + fr, col0 = u.pn * 256 + wc * 32 + 8 * fq;
#pragma unroll
        for (int ai = 0; ai < 2; ++ai)
#pragma unroll
            for (int m = 0; m < 4; ++m) { bf16_t* rowp = O + (size_t)(row0 + ai * 128 + m * 16) * ldc + col0;
#pragma unroll
                for (int bj = 0; bj < 2; ++bj) { const pg8::f32x4 v0 = acc[ai][bj][m][0], v1 = acc[ai][bj][m][1];
                    v4u w; w.x = pk2(v0[0], v0[1]); w.y = pk2(v0[2], v0[3]); w.z = pk2(v1[0], v1[1]); w.w = pk2(v1[2], v1[3]);
                    *(v4u*)(rowp + bj * 128) = w; } }
    }
};
struct EpiGated {
    static constexpr bool PERM = true, AFTER_DRAIN = false;
    bf16_t* O;
    DEV void operator()(const pg8::f32x4 (&acc)[2][2][4][2], const pg8::Unit& u, int wr, int wc, int fr, int fq) const {
        const int row0 = u.pm * 256 + wr * 64 + fr, col0 = u.pn * 128 + wc * 32 + 8 * fq;
#pragma unroll
        for (int ai = 0; ai < 2; ++ai)
#pragma unroll
            for (int m = 0; m < 4; ++m) { bf16_t* rowp = O + (size_t)(row0 + ai * 128 + m * 16) * FFH + col0;
                float f[8];
#pragma unroll
                for (int n = 0; n < 2; ++n)
#pragma unroll
                    for (int j = 0; j < 4; ++j) f[n * 4 + j] = siluf_(acc[ai][0][m][n][j]) * acc[ai][1][m][n][j];
                *(v4u*)rowp = pack8(f); }
    }
};
struct EpiResid {
    static constexpr bool PERM = false, AFTER_DRAIN = false;
    const float* bA; const float* bB; int rowoffB; float* out; const float* gate;
    DEV void operator()(const pg8::f32x4 (&acc)[2][2][4][2], const pg8::Unit& u, int wr, int wc, int fr, int fq) const {
        const int row0 = u.pm * 256 + wr * 64 + fr, col0 = u.pn * 256 + wc * 32 + 4 * fq;
        const int mr = u.pm < 16 ? 0 : 1 + ((u.pm - 16) >> 2);
        const float* g = gate + (size_t)mr * NMOD + col0;
        pg8::f32x4 gv[2][2];
#pragma unroll
        for (int bj = 0; bj < 2; ++bj)
#pragma unroll
            for (int n = 0; n < 2; ++n) gv[bj][n] = *(const pg8::f32x4*)(g + bj * 128 + n * 16);
#pragma unroll
        for (int ai = 0; ai < 2; ++ai)
#pragma unroll
            for (int m = 0; m < 4; ++m) { const int r = row0 + ai * 128 + m * 16;
                const float* bp = (r < NTP ? bA + (size_t)r * DM : bB + (size_t)(r - rowoffB) * DM) + col0; float* op = out + (size_t)r * DM + col0;
#pragma unroll
                for (int bj = 0; bj < 2; ++bj)
#pragma unroll
                    for (int n = 0; n < 2; ++n) { const pg8::f32x4 b = *(const pg8::f32x4*)(bp + bj * 128 + n * 16);
                        *(pg8::f32x4*)(op + bj * 128 + n * 16) = b + gv[bj][n] * acc[ai][bj][m][n]; } }
    }
};
struct EpiGlu {
    static constexpr bool PERM = true, AFTER_DRAIN = false;
    const bf16_t* Z; bf16_t* MIX; const float* bias;
    DEV void operator()(const pg8::f32x4 (&acc)[2][2][4][2], const pg8::Unit& u, int wr, int wc, int fr, int fq) const {
        const int row0 = u.pm * 256 + wr * 64 + fr, col0 = u.pn * 256 + wc * 32 + 8 * fq;
#pragma unroll
        for (int bj = 0; bj < 2; ++bj) { const int c = col0 + bj * 128;
            const v4f b0 = *(const v4f*)(bias + c), b1 = *(const v4f*)(bias + c + 4);
#pragma unroll
            for (int ai = 0; ai < 2; ++ai)
#pragma unroll
                for (int m = 0; m < 4; ++m) { const int r = row0 + ai * 128 + m * 16;
                    float z[8]; unpack8(*(const v4u*)(Z + (size_t)r * 512 + c), z);
                    float f[8];
#pragma unroll
                    for (int j = 0; j < 4; ++j) { f[j] = z[j] * sigmoidf_(acc[ai][bj][m][0][j] + b0[j]); f[4 + j] = z[4 + j] * sigmoidf_(acc[ai][bj][m][1][j] + b1[j]); }
                    *(v4u*)(MIX + (size_t)r * DM + 1536 + c) = pack8(f); } }
    }
};

DEV void tr_item(const float* W, int ldw, int srcc0, bf16_t* WT, int Kd, int dstr0, int k0, LAS float* scr, int lane) {
    {
        const int c4 = (lane & 7) * 4, kr = lane >> 3;
        v4f t[8];
#pragma unroll
        for (int i = 0; i < 8; ++i) t[i] = *(const v4f*)(W + (size_t)(k0 + kr + 8 * i) * ldw + srcc0 + c4);
#pragma unroll
        for (int i = 0; i < 8; ++i) { LAS float* d = scr + (kr + 8 * i) * 33 + c4; d[0] = t[i].x; d[1] = t[i].y; d[2] = t[i].z; d[3] = t[i].w; }
    }
    LDS_WAIT();
    const int c = lane & 7;
#pragma unroll
    for (int j = 0; j < 4; ++j) { const int n = (lane >> 3) + 8 * j; const LAS float* s = scr + (8 * c) * 33 + n;
        v4u o; o.x = pk2(s[0 * 33], s[1 * 33]); o.y = pk2(s[2 * 33], s[3 * 33]); o.z = pk2(s[4 * 33], s[5 * 33]); o.w = pk2(s[6 * 33], s[7 * 33]);
        *(v4u*)(WT + (size_t)(dstr0 + n) * Kd + k0 + 8 * c) = o; }
    LDS_WAIT();
}

DEV void phase0(const Params& p, LAS unsigned char* lds, const int wave) {
    const int lane = lane_id_(), tid = wave * 64 + lane;
    const int gtid = blockIdx.x * NTHREADS + tid, NT = gridDim.x * NTHREADS;
    unsigned char* ws = p.ws;
    {
        float* LB = (float*)(ws + WS_LB); const float* lp = p.in[I_HLB];
        for (int i = gtid; i < 1024; i += NT) { const float a = lp[i], b = lp[1024 + i], m = fmaxf(a, b); const float ea = expf(a - m), eb = expf(b - m);
            LB[i] = 0.f; LB[1024 + i] = eb / (ea + eb); }
    }
    {
        float* AR = (float*)(ws + WS_S5A); float* AI = AR + 8192; float* BR = (float*)(ws + WS_S5B); float* BI = BR + 131072;
        for (int i = gtid; i < 8192; i += NT) {
            const float are = p.in[I_SARE][i], aim = p.in[I_SAIM][i], dt = expf(p.in[I_SLOG][i >> 6]);
            const float mag = expf(are * dt); float sn, cs; sincosf(aim * dt, &sn, &cs);
            const float abr = mag * cs, abi = mag * sn; AR[i] = abr; AI[i] = abi;
            const float den = are * are + aim * aim, nr = abr - 1.0f;
            const float fre = (nr * are + abi * aim) / den, fim = (abi * are - nr * aim) / den;
            for (int c = 0; c < 16; ++c) { const float br = p.in[I_SBRE][i * 16 + c], bi = p.in[I_SBIM][i * 16 + c];
                BR[i * 16 + c] = fre * br - fim * bi; BI[i * 16 + c] = fre * bi + fim * br; }
        }
    }
    {
        float* RC = (float*)(ws + WS_ROPE); float* RS = RC + 65536;
        for (int i = gtid; i < 65536; i += NT) { const int pos = i >> 6, j = i & 63, fi = j & 31;
            const float inv = expf(-(float)fi * (9.210340371976184f / 32.0f)); const float t = (float)(j < 32 ? (pos >> 6) : (pos & 63));
            float sn, cs; sincosf(t * inv, &sn, &cs); RC[i] = cs; RS[i] = sn; }
    }
    {
        float* WT = (float*)(ws + WS_WABT);
        for (int i = gtid; i < 2 * 16 * DM; i += NT) { const int l = i >> 15, q = (i >> 11) & 15, c = i & 2047; WT[i] = p.in[I_INP][(size_t)l * DM * 7184 + (size_t)c * 7184 + 4096 + q]; }
    }
    if ((int)blockIdx.x < 192) {
        LAS float* sc = (LAS float*)lds;
        LAS float* red = (LAS float*)(lds + 73728);
        for (int i = tid; i < 9 * 2048; i += NTHREADS) { const int r = i >> 11, k = i & 2047; const float v = (r == 0) ? p.in[I_CCTX][k] : p.in[I_C][(r - 1) * 2048 + k]; sc[i] = siluf_(v); }
        __syncthreads();
        for (int item = blockIdx.x; item < 192; item += gridDim.x) {
            const int l = item / 96, j0 = (item % 96) * 128;
            const float* W = p.in[I_ADAW] + (size_t)l * DM * NMOD + j0 + lane * 2;
            v2f acc[9];
#pragma unroll
            for (int r = 0; r < 9; ++r) acc[r] = (v2f){0.f, 0.f};
            for (int k = wave * 256; k < wave * 256 + 256; k += 16) {
                v2f w[16];
#pragma unroll
                for (int q = 0; q < 16; ++q) w[q] = __builtin_nontemporal_load((const v2f*)(W + (size_t)(k + q) * NMOD));
#pragma unroll
                for (int q4 = 0; q4 < 4; ++q4)
#pragma unroll
                    for (int r = 0; r < 9; ++r) { const v4f s = *(const LAS v4f*)(sc + r * 2048 + k + 4 * q4);
                        acc[r] += w[4 * q4] * s.x; acc[r] += w[4 * q4 + 1] * s.y; acc[r] += w[4 * q4 + 2] * s.z; acc[r] += w[4 * q4 + 3] * s.w; }
            }
#pragma unroll
            for (int r = 0; r < 9; ++r) { red[(wave * 18 + r * 2) * 64 + lane] = acc[r].x; red[(wave * 18 + r * 2 + 1) * 64 + lane] = acc[r].y; }
            __syncthreads();
            for (int o = tid; o < 18 * 64; o += NTHREADS) { const int rr = o >> 6, ln = o & 63; float s = 0.f;
#pragma unroll
                for (int w = 0; w < 8; ++w) s += red[(w * 18 + rr) * 64 + ln];
                const int r = rr >> 1, j = j0 + ln * 2 + (rr & 1);
                ((float*)(ws + WS_MOD))[(size_t)(l * 9 + r) * NMOD + j] = s + p.in[I_ADAB][l * NMOD + j]; }
            __syncthreads();
        }
    }
    __syncthreads();
    {
        LAS float* scr = (LAS float*)(lds + wave * 8448);
        const int gw = blockIdx.x * NWAVES + wave, NGW = gridDim.x * NWAVES;
        constexpr int I_IN = 32 * 224, I_OUT = 32 * 64, I_13 = 32 * 352, I_2 = 88 * 64, I_G = 8 * 16, I_L = I_IN + I_OUT + I_13 + I_2 + I_G;
        for (int it = gw; it < 2 * I_L; it += NGW) {
            const int l = it / I_L; int r = it % I_L;
            if (r < I_IN) { const int kb = r / 224, nb = r % 224, n0 = nb * 32;
                tr_item(p.in[I_INP] + (size_t)l * DM * 7184, 7184, n0 < 4096 ? n0 : n0 + 16, (bf16_t*)(ws + WS_WIN) + (size_t)l * PW * DM, DM, n0, kb * 64, scr, lane); continue; }
            r -= I_IN;
            if (r < I_OUT) { const int kb = r / 64, nb = r % 64;
                tr_item(p.in[I_OUTP] + (size_t)l * DM * DM, DM, nb * 32, (bf16_t*)(ws + WS_WOUT) + (size_t)l * DM * DM, DM, nb * 32, kb * 64, scr, lane); continue; }
            r -= I_OUT;
            if (r < I_13) { const int kb = r / 352, nb = r % 352, n0 = nb * 32, tile = n0 >> 8, within = n0 & 255;
                const float* src = (within < 128 ? p.in[I_W1] : p.in[I_W3]) + (size_t)l * DM * FFH;
                tr_item(src, FFH, tile * 128 + (within & 127), (bf16_t*)(ws + WS_W13) + (size_t)l * 2 * FFH * DM, DM, n0, kb * 64, scr, lane); continue; }
            r -= I_13;
            if (r < I_2) { const int kb = r / 64, nb = r % 64;
                tr_item(p.in[I_W2] + (size_t)l * FFH * DM, DM, nb * 32, (bf16_t*)(ws + WS_W2) + (size_t)l * DM * FFH, FFH, nb * 32, kb * 64, scr, lane); continue; }
            r -= I_2;
            { const int kb = r / 16, nb = r % 16;
                tr_item(p.in[I_GLUW] + (size_t)l * 512 * 512, 512, nb * 32, (bf16_t*)(ws + WS_WGLU) + (size_t)l * 512 * 512, 512, nb * 32, kb * 64, scr, lane); }
        }
    }
}

template <int WHICH> DEV void norm_phase(const Params& p, int l, const int wave) {
    const int lane = lane_id_();
    const int gw = blockIdx.x * NWAVES + wave, NGW = gridDim.x * NWAVES;
    unsigned char* ws = p.ws;
    const float* XR = (const float*)(ws + WS_XRES);
    for (int row = gw; row < T_TOK; row += NGW) {
        const float* x;
        if (WHICH == 0 && l == 0) x = row < NTP ? p.in[I_XP] + (size_t)row * DM : p.in[I_XS] + (size_t)(row - NTP) * DM; else x = XR + (size_t)row * DM;
        v4f v[8]; float ss = 0.f;
#pragma unroll
        for (int j = 0; j < 8; ++j) { v[j] = *(const v4f*)(x + lane * 4 + 256 * j); ss += (v[j].x * v[j].x + v[j].y * v[j].y) + (v[j].z * v[j].z + v[j].w * v[j].w); }
        const float rstd = rsqrtf(wave_sum(ss) * (1.0f / DM) + EPSN);
        if (WHICH == 2) {
            const float* w = p.in[I_FNW]; float* o = p.out + O_Y + (size_t)row * DM;
#pragma unroll
            for (int j = 0; j < 8; ++j) { const v4f wv = *(const v4f*)(w + lane * 4 + 256 * j); __builtin_nontemporal_store(v[j] * rstd * wv, (v4f*)(o + lane * 4 + 256 * j)); }
        } else {
            const float* mod = (const float*)(ws + WS_MOD) + (size_t)(l * 9 + mod_row_of(row)) * NMOD;
            const float* shift = mod + (WHICH ? 3 : 0) * DM; const float* scale = mod + (WHICH ? 4 : 1) * DM;
            const float* w = p.in[WHICH ? I_N2W : I_N1W] + l * DM;
            bf16_t* o = (bf16_t*)(ws + WS_HB) + (size_t)row * DM;
#pragma unroll
            for (int j = 0; j < 8; ++j) { const int c = lane * 4 + 256 * j;
                const v4f wv = *(const v4f*)(w + c), sh = *(const v4f*)(shift + c), scl = *(const v4f*)(scale + c);
                const v4f h = v[j] * rstd * wv * (1.0f + scl) + sh; v[j] = h;
                v2u pk; pk.x = pk2(h.x, h.y); pk.y = pk2(h.z, h.w); *(v2u*)(o + c) = pk; }
            if (WHICH == 0) {
                const float* wt = (const float*)(ws + WS_WABT) + (size_t)l * 16 * DM + lane * 4; float mine = 0.f;
#pragma unroll 2
                for (int q = 0; q < 16; ++q) { float s = 0.f;
#pragma unroll
                    for (int j = 0; j < 8; ++j) { const v4f wq = *(const v4f*)(wt + q * DM + 256 * j); s += (v[j].x * wq.x + v[j].y * wq.y) + (v[j].z * wq.z + v[j].w * wq.w); }
                    s = wave_sum(s); mine = (lane == q) ? s : mine; }
                if (lane < 16) ((float*)(ws + WS_AB))[(size_t)row * 16 + lane] = mine;
            }
        }
    }
}

constexpr int NB = 32;
template <int MT> DEV void chain_task(const Params& p, int l, int seq, int hh, int dir, LAS float* lds, const int wave) {
    const int lane = lane_id_(), tid = wave * 64 + lane, dg = lane & 15, eg = lane >> 4;
    const int L = seq_len(seq), tok0 = seq_tok0(seq); const bool samp = seq >= 16;
    const int e0 = wave * 16 + eg * 4, d0 = dg * 8;
    unsigned char* ws = p.ws;
    const bf16_t* PROJ = (const bf16_t*)(ws + WS_PROJ);
    float* OB = (float*)(ws + WS_OBUF) + (size_t)dir * T_TOK * DM + MT * 512 + hh * 128 + e0;
    LAS float* qs = lds; LAS float* ks = lds + NB * 128; LAS float* vs = lds + 2 * NB * 128; LAS float* fs = lds + 3 * NB * 128; LAS float* scl = lds + 4 * NB * 128;
    v4f S[8];
    if (samp) { const float* st = p.in[MT == 0 ? I_SRET : (MT == 1 ? I_SGDN : I_SHG)] + ((((size_t)(seq - 16) * 2 + l) * 2 + dir) * 4 + hh) * 16384;
#pragma unroll
        for (int i = 0; i < 8; ++i) S[i] = *(const v4f*)(st + (d0 + i) * 128 + e0);
    } else {
#pragma unroll
        for (int i = 0; i < 8; ++i) S[i] = (v4f){0.f, 0.f, 0.f, 0.f};
    }
    float gam = 1.f;
    if (MT == 0) gam = sigmoidf_(p.in[I_RETL][(l * 2 + dir) * 4 + hh]);
    const int ti = tid >> 4, sub = tid & 15, c0 = sub * 8, ch = hh * 128 + c0;
    for (int b0 = 0; b0 < L; b0 += NB) {
        __syncthreads();
        {
            const int st = b0 + ti, pos = dir ? L - 1 - st : st, tok = tok0 + pos;
            const bf16_t* row = PROJ + (size_t)tok * PW;
            float q[8], k[8], v[8];
            if (MT == 0) {
                unpack8(*(const v4u*)(row + ch), q); unpack8(*(const v4u*)(row + 512 + ch), k); unpack8(*(const v4u*)(row + 1024 + ch), v);
                if (samp) {
                    float qp[8], kp[8]; unpack8(*(const v4u*)(row + (ch ^ 64)), qp); unpack8(*(const v4u*)(row + 512 + (ch ^ 64)), kp);
                    const float* RC = (const float*)(ws + WS_ROPE) + pos * 64 + (c0 & 63); const float* RS = RC + 65536;
#pragma unroll
                    for (int i = 0; i < 8; ++i) { const float cs = RC[i], sn = RS[i];
                        if (sub < 8) { q[i] = q[i] * cs - qp[i] * sn; k[i] = k[i] * cs - kp[i] * sn; }
                        else { q[i] = qp[i] * sn + q[i] * cs; k[i] = kp[i] * sn + k[i] * cs; } }
                }
#pragma unroll
                for (int i = 0; i < 8; ++i) k[i] *= HD_SCALE;
            } else if (MT == 1) {
                const float* cw = p.in[I_GCONV] + (size_t)l * 3 * 1536 + ch;
                const bool hm = pos > 0, hp = pos + 1 < L;
#pragma unroll
                for (int part = 0; part < 3; ++part) {
                    float xm[8], x0[8], xp[8]; const bf16_t* src = row + (4 + part) * 512 + ch;
                    unpack8(*(const v4u*)src, x0);
                    if (hm) unpack8(*(const v4u*)(src - PW), xm); else {
#pragma unroll
                        for (int i = 0; i < 8; ++i) xm[i] = 0.f; }
                    if (hp) unpack8(*(const v4u*)(src + PW), xp); else {
#pragma unroll
                        for (int i = 0; i < 8; ++i) xp[i] = 0.f; }
                    const float* w = cw + part * 512;
#pragma unroll
                    for (int i = 0; i < 8; ++i) { const float y = xm[i] * w[i] + x0[i] * w[1536 + i] + xp[i] * w[3072 + i]; const float s = siluf_(y);
                        if (part == 0) q[i] = s; else if (part == 1) k[i] = s; else v[i] = s; }
                }
                float sq = 0.f, sk = 0.f;
#pragma unroll
                for (int i = 0; i < 8; ++i) { sq += q[i] * q[i]; sk += k[i] * k[i]; }
                sq = row16_sum(sq); sk = row16_sum(sk);
                const float rq = rsqrtf(sq + EPSN) * HD_SCALE, rk = rsqrtf(sk + EPSN);
                float kq = 0.f;
#pragma unroll
                for (int i = 0; i < 8; ++i) { q[i] *= rq; k[i] *= rk; kq += q[i] * k[i]; }
                kq = row16_sum(kq);
                if (sub == 0) {
                    const float* AB = (const float*)(ws + WS_AB) + (size_t)tok * 16;
                    const float ap = AB[dir * 4 + hh] + p.in[I_GDTB][(l * 2 + dir) * 4 + hh], bp = AB[8 + dir * 4 + hh];
                    const float sp = fmaxf(ap, 0.f) + log1pf(expf(-fabsf(ap)));
                    const float alpha = expf(-expf(p.in[I_GALOG][(l * 2 + dir) * 4 + hh]) * sp);
                    *(LAS v4f*)(scl + ti * 4) = (v4f){alpha, sigmoidf_(bp), kq, 0.f};
                }
            } else {
                float fx[8], f[8]; unpack8(*(const v4u*)(row + 8 * 512 + ch), q); unpack8(*(const v4u*)(row + (9 + dir) * 512 + ch), fx); unpack8(*(const v4u*)(row + 11 * 512 + ch), v);
                const float* LB = (const float*)(ws + WS_LB) + (l * 2 + dir) * 512 + ch;
#pragma unroll
                for (int i = 0; i < 8; ++i) { const float lb = LB[i]; q[i] = siluf_(q[i]) * HD_SCALE; f[i] = lb + (1.0f - lb) * sigmoidf_(fx[i]); k[i] = (1.0f - lb) * sigmoidf_(-fx[i]); }
                *(LAS v4f*)(fs + ti * 128 + c0) = (v4f){f[0], f[1], f[2], f[3]}; *(LAS v4f*)(fs + ti * 128 + c0 + 4) = (v4f){f[4], f[5], f[6], f[7]};
            }
            *(LAS v4f*)(qs + ti * 128 + c0) = (v4f){q[0], q[1], q[2], q[3]}; *(LAS v4f*)(qs + ti * 128 + c0 + 4) = (v4f){q[4], q[5], q[6], q[7]};
            *(LAS v4f*)(ks + ti * 128 + c0) = (v4f){k[0], k[1], k[2], k[3]}; *(LAS v4f*)(ks + ti * 128 + c0 + 4) = (v4f){k[4], k[5], k[6], k[7]};
            *(LAS v4f*)(vs + ti * 128 + c0) = (v4f){v[0], v[1], v[2], v[3]}; *(LAS v4f*)(vs + ti * 128 + c0 + 4) = (v4f){v[4], v[5], v[6], v[7]};
        }
        __syncthreads();
#pragma unroll 2
        for (int i = 0; i < NB; ++i) {
            const v4f ka = *(const LAS v4f*)(ks + i * 128 + d0), kb = *(const LAS v4f*)(ks + i * 128 + d0 + 4);
            const v4f qa = *(const LAS v4f*)(qs + i * 128 + d0), qb = *(const LAS v4f*)(qs + i * 128 + d0 + 4);
            const v4f vv = *(const LAS v4f*)(vs + i * 128 + e0);
            const float kk[8] = {ka.x, ka.y, ka.z, ka.w, kb.x, kb.y, kb.z, kb.w};
            const float qq[8] = {qa.x, qa.y, qa.z, qa.w, qb.x, qb.y, qb.z, qb.w};
            v4f o = (v4f){0.f, 0.f, 0.f, 0.f};
            if (MT == 0) {
#pragma unroll
                for (int d = 0; d < 8; ++d) { S[d] = S[d] * gam + vv * kk[d]; o += S[d] * qq[d]; }
            } else if (MT == 2) {
                const v4f fa = *(const LAS v4f*)(fs + i * 128 + d0), fb = *(const LAS v4f*)(fs + i * 128 + d0 + 4);
                const float ff[8] = {fa.x, fa.y, fa.z, fa.w, fb.x, fb.y, fb.z, fb.w};
#pragma unroll
                for (int d = 0; d < 8; ++d) { S[d] = S[d] * ff[d] + vv * kk[d]; o += S[d] * qq[d]; }
            } else {
                const v4f sc4 = *(const LAS v4f*)(scl + i * 4);
                v4f r = (v4f){0.f, 0.f, 0.f, 0.f};
#pragma unroll
                for (int d = 0; d < 8; ++d) { S[d] = S[d] * sc4.x; r += S[d] * kk[d]; o += S[d] * qq[d]; }
                r.x = row16_sum(r.x); r.y = row16_sum(r.y); r.z = row16_sum(r.z); r.w = row16_sum(r.w);
                const v4f vn = (vv - r) * sc4.y;
#pragma unroll
                for (int d = 0; d < 8; ++d) S[d] += vn * kk[d];
                o.x = row16_sum(o.x); o.y = row16_sum(o.y); o.z = row16_sum(o.z); o.w = row16_sum(o.w);
                o += vn * sc4.z;
            }
            if (MT != 1) { o.x = row16_sum(o.x); o.y = row16_sum(o.y); o.z = row16_sum(o.z); o.w = row16_sum(o.w); }
            if (dg == 0) { const int st = b0 + i, pos = dir ? L - 1 - st : st; *(v4f*)(OB + (size_t)(tok0 + pos) * DM) = o; }
        }
    }
    if (!samp) { float* so = p.out + (MT == 0 ? O_RET : (MT == 1 ? O_GDN : O_HG)) + ((((size_t)seq * 2 + l) * 2 + dir) * 4 + hh) * 16384;
#pragma unroll
        for (int i = 0; i < 8; ++i) *(v4f*)(so + (d0 + i) * 128 + e0) = S[i]; }
}

typedef short s4v __attribute__((ext_vector_type(4)));
typedef short s8v __attribute__((ext_vector_type(8)));
DEV s4v cvt4(v4f x) { v2u w; w.x = pk2(x.x, x.y); w.y = pk2(x.z, x.w); return __builtin_bit_cast(s4v, w); }
DEV s8v cat8(s4v a, s4v b) { return __builtin_shufflevector(a, b, 0, 1, 2, 3, 4, 5, 6, 7); }
DEV unsigned short bf1(float x) { return (unsigned short)(pk2(x, x) & 0xffffu); }
constexpr int QI_OFF = 65536, KI_OFF = 74240, KBT_OFF = 82944, VT_OFF = 92160, EBC_OFF = 101376;
template <int MT> DEV void gla_task(const Params& p, int l, int seq, int hh, int dir, LAS unsigned char* lds, const int wave) {
    const int lane = lane_id_(), tid = wave * 64 + lane, g = lane >> 4, r15 = lane & 15;
    const int L = seq_len(seq), tok0 = seq_tok0(seq); const bool samp = seq >= 16;
    unsigned char* ws = p.ws;
    const bf16_t* PROJ = (const bf16_t*)(ws + WS_PROJ);
    float* OBc = (float*)(ws + WS_OBUF) + (size_t)dir * T_TOK * DM + MT * 512 + hh * 128 + 16 * wave + r15;
    LAS float* qf = (LAS float*)lds; LAS float* kf = qf + 4096; LAS float* vf = kf + 4096; LAS float* ff = vf + 4096;
    v4f acc[8];
    if (samp) { const float* st = p.in[MT == 0 ? I_SRET : I_SHG] + ((((size_t)(seq - 16) * 2 + l) * 2 + dir) * 4 + hh) * 16384 + 16 * wave + r15;
#pragma unroll
        for (int dt = 0; dt < 8; ++dt)
#pragma unroll
            for (int r = 0; r < 4; ++r) acc[dt][r] = st[(16 * dt + 4 * g + r) * 128];
    } else {
#pragma unroll
        for (int dt = 0; dt < 8; ++dt) acc[dt] = (v4f){0.f, 0.f, 0.f, 0.f};
    }
    float gam = 1.f;
    if (MT == 0) gam = sigmoidf_(p.in[I_RETL][(l * 2 + dir) * 4 + hh]);
    const int ti = tid >> 4, sub = tid & 15, c0 = sub * 8, ch = hh * 128 + c0;
    const int cB = tid & 127, qd = tid >> 7, sB = qd >> 1, hB = qd & 1;
    for (int b0 = 0; b0 < L; b0 += 32) {
        __syncthreads();
        {
            const int st = b0 + ti, pos = dir ? L - 1 - st : st, tok = tok0 + pos;
            const bf16_t* row = PROJ + (size_t)tok * PW;
            float q[8], k[8], v[8];
            if (MT == 0) {
                unpack8(*(const v4u*)(row + ch), q); unpack8(*(const v4u*)(row + 512 + ch), k); unpack8(*(const v4u*)(row + 1024 + ch), v);
                if (samp) {
                    float qp[8], kp[8]; unpack8(*(const v4u*)(row + (ch ^ 64)), qp); unpack8(*(const v4u*)(row + 512 + (ch ^ 64)), kp);
                    const float* RC = (const float*)(ws + WS_ROPE) + pos * 64 + (c0 & 63); const float* RS = RC + 65536;
                    const v4f ca = *(const v4f*)RC, cb = *(const v4f*)(RC + 4), sa = *(const v4f*)RS, sb = *(const v4f*)(RS + 4);
                    const float cs[8] = {ca.x, ca.y, ca.z, ca.w, cb.x, cb.y, cb.z, cb.w}, sn[8] = {sa.x, sa.y, sa.z, sa.w, sb.x, sb.y, sb.z, sb.w};
#pragma unroll
                    for (int i = 0; i < 8; ++i) {
                        if (sub < 8) { q[i] = q[i] * cs[i] - qp[i] * sn[i]; k[i] = k[i] * cs[i] - kp[i] * sn[i]; }
                        else { q[i] = qp[i] * sn[i] + q[i] * cs[i]; k[i] = kp[i] * sn[i] + k[i] * cs[i]; } }
                }
#pragma unroll
                for (int i = 0; i < 8; ++i) k[i] *= HD_SCALE;
            } else {
                float fx[8], f[8]; unpack8(*(const v4u*)(row + 8 * 512 + ch), q); unpack8(*(const v4u*)(row + (9 + dir) * 512 + ch), fx); unpack8(*(const v4u*)(row + 11 * 512 + ch), v);
                const float* LB = (const float*)(ws + WS_LB) + (l * 2 + dir) * 512 + ch;
                const v4f la = *(const v4f*)LB, lb4 = *(const v4f*)(LB + 4); const float lbv[8] = {la.x, la.y, la.z, la.w, lb4.x, lb4.y, lb4.z, lb4.w};
#pragma unroll
                for (int i = 0; i < 8; ++i) { const float lb = lbv[i]; q[i] = siluf_(q[i]) * HD_SCALE; f[i] = lb + (1.0f - lb) * sigmoidf_(fx[i]); k[i] = (1.0f - lb) * sigmoidf_(-fx[i]); }
                *(LAS v4f*)(ff + ti * 128 + c0) = (v4f){f[0], f[1], f[2], f[3]}; *(LAS v4f*)(ff + ti * 128 + c0 + 4) = (v4f){f[4], f[5], f[6], f[7]};
            }
            *(LAS v4f*)(qf + ti * 128 + c0) = (v4f){q[0], q[1], q[2], q[3]}; *(LAS v4f*)(qf + ti * 128 + c0 + 4) = (v4f){q[4], q[5], q[6], q[7]};
            *(LAS v4f*)(kf + ti * 128 + c0) = (v4f){k[0], k[1], k[2], k[3]}; *(LAS v4f*)(kf + ti * 128 + c0 + 4) = (v4f){k[4], k[5], k[6], k[7]};
            *(LAS v4f*)(vf + ti * 128 + c0) = (v4f){v[0], v[1], v[2], v[3]}; *(LAS v4f*)(vf + ti * 128 + c0 + 4) = (v4f){v[4], v[5], v[6], v[7]};
        }
        __syncthreads();
        {
            const int jo = 16 * sB + 8 * hB, jx = 16 * sB + 8 * (1 - hB);
            float own[8], po = 1.f;
#pragma unroll
            for (int t = 0; t < 8; ++t) { own[t] = (MT == 0) ? gam : ff[(jo + t) * 128 + cB]; po *= (MT == 0) ? gam : ff[(jx + t) * 128 + cB]; }
            float Fm[8]; float run = hB ? po : 1.0f;
#pragma unroll
            for (int t = 0; t < 8; ++t) { run *= own[t]; Fm[t] = run; }
            const float FC = hB ? run : run * po;
            float kb[8], vv[8];
#pragma unroll
            for (int t = 0; t < 8; ++t) { const float inv = 1.0f / Fm[t]; const int j = jo + t;
                const float kv = kf[j * 128 + cB] * inv;
                *(LAS unsigned short*)(lds + QI_OFF + j * 272 + cB * 2) = bf1(qf[j * 128 + cB] * Fm[t]);
                *(LAS unsigned short*)(lds + KI_OFF + j * 272 + cB * 2) = bf1(kv);
                kb[t] = kv * FC; vv[t] = vf[j * 128 + cB]; }
            { const v4u a = pack8(kb), b = pack8(vv); const int off = cB * 72 + (16 * sB + 8 * hB) * 2;
              *(LAS v2u*)(lds + KBT_OFF + off) = (v2u){a.x, a.y}; *(LAS v2u*)(lds + KBT_OFF + off + 8) = (v2u){a.z, a.w};
              *(LAS v2u*)(lds + VT_OFF + off) = (v2u){b.x, b.y}; *(LAS v2u*)(lds + VT_OFF + off + 8) = (v2u){b.z, b.w}; }
            if (hB == 0) *(LAS float*)(lds + EBC_OFF + (sB * 128 + cB) * 4) = FC;
        }
        __syncthreads();
#pragma unroll
        for (int s = 0; s < 2; ++s) {
            const int jb = 16 * s;
            mfma_fence8(acc);
            v4f pt = (v4f){0.f, 0.f, 0.f, 0.f};
#pragma unroll
            for (int ks = 0; ks < 4; ++ks) { const int off = (jb + r15) * 272 + (32 * ks + 8 * g) * 2;
                pt = __builtin_amdgcn_mfma_f32_16x16x32_bf16(*(const LAS s8v*)(lds + KI_OFF + off), *(const LAS s8v*)(lds + QI_OFF + off), pt, 0, 0, 0); }
            v4f pm;
#pragma unroll
            for (int r = 0; r < 4; ++r) pm[r] = (4 * g + r <= r15) ? pt[r] : 0.f;
            const s4v pa = cvt4(pm);
            const s4v vb = *(const LAS s4v*)(lds + VT_OFF + (16 * wave + r15) * 72 + (jb + 4 * g) * 2);
            s8v sb[4];
#pragma unroll
            for (int kp = 0; kp < 4; ++kp) sb[kp] = cat8(cvt4(acc[2 * kp]), cvt4(acc[2 * kp + 1]));
            asm volatile("s_nop 4" : "+v"(sb[0]), "+v"(sb[1]), "+v"(sb[2]), "+v"(sb[3]));
            v4f o = __builtin_amdgcn_mfma_f32_16x16x16bf16_1k(pa, vb, (v4f){0.f, 0.f, 0.f, 0.f}, 0, 0, 0);
#pragma unroll
            for (int kp = 0; kp < 4; ++kp) { const int off = (jb + r15) * 272 + (32 * kp + 4 * g) * 2;
                const s8v qa = cat8(*(const LAS s4v*)(lds + QI_OFF + off), *(const LAS s4v*)(lds + QI_OFF + off + 32));
                o = __builtin_amdgcn_mfma_f32_16x16x32_bf16(qa, sb[kp], o, 0, 0, 0); }
#pragma unroll
            for (int r = 0; r < 4; ++r) { const int st = b0 + jb + 4 * g + r, pos = dir ? L - 1 - st : st; OBc[(size_t)(tok0 + pos) * DM] = o[r]; }
#pragma unroll
            for (int dt = 0; dt < 8; ++dt) { const v4f sc = *(const LAS v4f*)(lds + EBC_OFF + (s * 128 + 16 * dt + 4 * g) * 4);
                const s4v ka = *(const LAS s4v*)(lds + KBT_OFF + (16 * dt + r15) * 72 + (jb + 4 * g) * 2);
                acc[dt] = __builtin_amdgcn_mfma_f32_16x16x16bf16_1k(ka, vb, acc[dt] * sc, 0, 0, 0); }
        }
    }
    if (!samp) { float* so = p.out + (MT == 0 ? O_RET : O_HG) + ((((size_t)seq * 2 + l) * 2 + dir) * 4 + hh) * 16384 + 16 * wave + r15;
#pragma unroll
        for (int dt = 0; dt < 8; ++dt)
#pragma unroll
            for (int r = 0; r < 4; ++r) so[(16 * dt + 4 * g + r) * 128] = acc[dt][r]; }
}

constexpr int GD_KF = 0, GD_VF = 16384, GD_QI = 32768, GD_KI = GD_QI + 8704, GD_GQ = GD_KI + 8704, GD_NW = GD_GQ + 8704, GD_KT0 = GD_NW + 8704, GD_KBT = GD_KT0 + 9216, GD_VT = GD_KBT + 9216,
              GD_UP = GD_VT + 9216, GD_TB = GD_UP + 1280, GD_AT = GD_TB + 1280, GD_AM = GD_AT + 1280, GD_SC = GD_AM + 2560, GD_GC = GD_SC + 1024, GD_CW = GD_GC + 16;
DEV void gdn_scalars(const Params& p, int l, int hh, int dir, int tok, LAS float* dst) {
    const float* AB = (const float*)(p.ws + WS_AB) + (size_t)tok * 16;
    const float ap = AB[dir * 4 + hh] + p.in[I_GDTB][(l * 2 + dir) * 4 + hh], bp = AB[8 + dir * 4 + hh];
    const float sp = fmaxf(ap, 0.f) + log1pf(expf(-fabsf(ap)));
    const float la = -expf(p.in[I_GALOG][(l * 2 + dir) * 4 + hh]) * sp;
    float gcum = la;
    { const int l15 = lane_id_() & 15;
#pragma unroll
      for (int off = 1; off < 16; off <<= 1) { const float y = __shfl_up(gcum, off, 16); gcum += (l15 >= off) ? y : 0.f; } }
    *(LAS v4f*)dst = (v4f){la, sigmoidf_(bp), gcum, 0.f};
}
DEV void gdn_task(const Params& p, int l, int seq, int hh, int dir, LAS unsigned char* lds, const int wave) {
    const int lane = lane_id_(), tid = wave * 64 + lane, g = lane >> 4, r15 = lane & 15;
    const int L = seq_len(seq), tok0 = seq_tok0(seq); const bool samp = seq >= 16;
    unsigned char* ws = p.ws;
    const bf16_t* PROJ = (const bf16_t*)(ws + WS_PROJ);
    float* OBc = (float*)(ws + WS_OBUF) + (size_t)dir * T_TOK * DM + 512 + hh * 128 + 16 * wave + r15;
    LAS float* kf = (LAS float*)(lds + GD_KF); LAS float* vf = (LAS float*)(lds + GD_VF);
    v4f acc[8];
    if (samp) { const float* st = p.in[I_SGDN] + ((((size_t)(seq - 16) * 2 + l) * 2 + dir) * 4 + hh) * 16384 + 16 * wave + r15;
#pragma unroll
        for (int dt = 0; dt < 8; ++dt)
#pragma unroll
            for (int r = 0; r < 4; ++r) acc[dt][r] = st[(16 * dt + 4 * g + r) * 128];
    } else {
#pragma unroll
        for (int dt = 0; dt < 8; ++dt) acc[dt] = (v4f){0.f, 0.f, 0.f, 0.f};
    }
    const int ti = tid >> 4, sub = tid & 15, c0 = sub * 8, ch = hh * 128 + c0;
    const int cB = tid & 127, qd = tid >> 7, sB = qd >> 1, hB = qd & 1;
    if (tid < 32) { const int pos = dir ? L - 1 - tid : tid; gdn_scalars(p, l, hh, dir, tok0 + pos, (LAS float*)(lds + GD_SC) + tid * 4); }
    if (tid < 288) { const int pk = tid >> 5, part = pk / 3, kk = pk % 3, c4 = (tid & 31) * 4;
        *(LAS v4f*)(lds + GD_CW + (pk * 128 + c4) * 4) = *(const v4f*)(p.in[I_GCONV] + (size_t)l * 3 * 1536 + kk * 1536 + part * 512 + hh * 128 + c4); }
    int cur = 0;
    for (int b0 = 0; b0 < L; b0 += 32, cur ^= 1) {
        __syncthreads();
        const LAS float* SC = (const LAS float*)(lds + GD_SC) + cur * 128;
        {
            if (tid < 32 && b0 + 32 < L) { const int st = b0 + 32 + tid, pos = dir ? L - 1 - st : st; gdn_scalars(p, l, hh, dir, tok0 + pos, (LAS float*)(lds + GD_SC) + (cur ^ 1) * 128 + tid * 4); }
            const int st = b0 + ti, pos = dir ? L - 1 - st : st, tok = tok0 + pos;
            const bf16_t* row = PROJ + (size_t)tok * PW;
            float q[8], k[8], v[8];
            const bool hm = pos > 0, hp = pos + 1 < L;
#pragma unroll
            for (int part = 0; part < 3; ++part) {
                float xm[8], x0[8], xp[8]; const bf16_t* src = row + (4 + part) * 512 + ch;
                unpack8(*(const v4u*)src, x0);
                if (hm) unpack8(*(const v4u*)(src - PW), xm); else {
#pragma unroll
                    for (int i = 0; i < 8; ++i) xm[i] = 0.f; }
                if (hp) unpack8(*(const v4u*)(src + PW), xp); else {
#pragma unroll
                    for (int i = 0; i < 8; ++i) xp[i] = 0.f; }
                const LAS float* w = (const LAS float*)(lds + GD_CW) + part * 384 + c0;
                const v4f w0a = *(const LAS v4f*)w, w0b = *(const LAS v4f*)(w + 4), w1a = *(const LAS v4f*)(w + 128), w1b = *(const LAS v4f*)(w + 132), w2a = *(const LAS v4f*)(w + 256), w2b = *(const LAS v4f*)(w + 260);
                const float w0[8] = {w0a.x, w0a.y, w0a.z, w0a.w, w0b.x, w0b.y, w0b.z, w0b.w}, w1[8] = {w1a.x, w1a.y, w1a.z, w1a.w, w1b.x, w1b.y, w1b.z, w1b.w},
                            w2[8] = {w2a.x, w2a.y, w2a.z, w2a.w, w2b.x, w2b.y, w2b.z, w2b.w};
#pragma unroll
                for (int i = 0; i < 8; ++i) { const float y = xm[i] * w0[i] + x0[i] * w1[i] + xp[i] * w2[i]; const float sv = siluf_(y);
                    if (part == 0) q[i] = sv; else if (part == 1) k[i] = sv; else v[i] = sv; }
            }
            float sq = 0.f, sk = 0.f;
#pragma unroll
            for (int i = 0; i < 8; ++i) { sq += q[i] * q[i]; sk += k[i] * k[i]; }
            sq = row16_sum(sq); sk = row16_sum(sk);
            const float rq = rsqrtf(sq + EPSN) * HD_SCALE, rk = rsqrtf(sk + EPSN);
            const float G = __expf(SC[ti * 4 + 2]);
            float gq[8];
#pragma unroll
            for (int i = 0; i < 8; ++i) { q[i] *= rq; k[i] *= rk; gq[i] = q[i] * G; }
            *(LAS v4u*)(lds + GD_QI + ti * 272 + c0 * 2) = pack8(q);
            *(LAS v4u*)(lds + GD_KI + ti * 272 + c0 * 2) = pack8(k);
            *(LAS v4u*)(lds + GD_GQ + ti * 272 + c0 * 2) = pack8(gq);
            *(LAS v4f*)(kf + ti * 128 + c0) = (v4f){k[0], k[1], k[2], k[3]}; *(LAS v4f*)(kf + ti * 128 + c0 + 4) = (v4f){k[4], k[5], k[6], k[7]};
            *(LAS v4f*)(vf + ti * 128 + c0) = (v4f){v[0], v[1], v[2], v[3]}; *(LAS v4f*)(vf + ti * 128 + c0 + 4) = (v4f){v[4], v[5], v[6], v[7]};
        }
        __syncthreads();
        {
            const int jo = 16 * sB + 8 * hB;
            float gj[8];
#pragma unroll
            for (int t = 0; t < 8; ++t) gj[t] = SC[(jo + t) * 4 + 2];
            const float gC = SC[(16 * sB + 15) * 4 + 2];
            float k0[8], kb[8], vv[8];
#pragma unroll
            for (int t = 0; t < 8; ++t) { const int j = jo + t; k0[t] = kf[j * 128 + cB]; kb[t] = k0[t] * __expf(gC - gj[t]); vv[t] = vf[j * 128 + cB]; }
            const v4u a = pack8(k0), b = pack8(kb), c = pack8(vv); const int off = cB * 72 + jo * 2;
            *(LAS v2u*)(lds + GD_KT0 + off) = (v2u){a.x, a.y}; *(LAS v2u*)(lds + GD_KT0 + off + 8) = (v2u){a.z, a.w};
            *(LAS v2u*)(lds + GD_KBT + off) = (v2u){b.x, b.y}; *(LAS v2u*)(lds + GD_KBT + off + 8) = (v2u){b.z, b.w};
            *(LAS v2u*)(lds + GD_VT + off) = (v2u){c.x, c.y}; *(LAS v2u*)(lds + GD_VT + off + 8) = (v2u){c.z, c.w};
            if (cB == 0 && hB == 0) *(LAS float*)(lds + GD_GC + sB * 4) = __expf(gC);
        }
        {
            const int s = (wave >> 1) & 1, typ = wave & 1;
            v4f d = (v4f){0.f, 0.f, 0.f, 0.f};
#pragma unroll
            for (int ks = 0; ks < 4; ++ks) { const int off = (16 * s + r15) * 272 + (32 * ks + 8 * g) * 2;
                d = __builtin_amdgcn_mfma_f32_16x16x32_bf16(*(const LAS s8v*)(lds + (typ ? GD_QI : GD_KI) + off), *(const LAS s8v*)(lds + GD_KI + off), d, 0, 0, 0); }
            const int ln2 = lane_id_(), j2 = ln2 & 15, g2 = ln2 >> 4;
            const float gjj = SC[(16 * s + j2) * 4 + 2];
#pragma unroll
            for (int r = 0; r < 4; ++r) { const int i = 4 * g2 + r; const v4f si = *(const LAS v4f*)(SC + (16 * s + i) * 4); const float e = __expf(si.z - gjj);
                if (typ == 0) *(LAS float*)(lds + GD_AM + ((s * 16 + i) * 20 + j2) * 4) = (i > j2) ? si.y * d[r] * e : 0.f;
                else *(LAS unsigned short*)(lds + GD_AT + (s * 16 + i) * 40 + j2 * 2) = bf1((i >= j2) ? d[r] * e : 0.f); }
        }
        __syncthreads();
        {
            const int ln3 = lane_id_(), s = (ln3 >> 4) & 1, c = ln3 & 15;
            const LAS float* AM = (const LAS float*)(lds + GD_AM) + s * 320;
            float t[16];
#pragma unroll
            for (int i = 0; i < 16; ++i) { float a = (i == c) ? 1.f : 0.f;
#pragma unroll
                for (int j4 = 0; j4 < (i + 3) / 4; ++j4) { const v4f ar = *(const LAS v4f*)(AM + i * 20 + j4 * 4);
                    if (j4 * 4 + 0 < i) a -= ar.x * t[j4 * 4 + 0]; if (j4 * 4 + 1 < i) a -= ar.y * t[j4 * 4 + 1]; if (j4 * 4 + 2 < i) a -= ar.z * t[j4 * 4 + 2]; if (j4 * 4 + 3 < i) a -= ar.w * t[j4 * 4 + 3]; }
                t[i] = a; }
            const v4f scc = *(const LAS v4f*)(SC + (16 * s + c) * 4);
            const float bc = scc.y, bge = bc * __expf(scc.z);
#pragma unroll
            for (int i = 0; i < 16; ++i) { *(LAS unsigned short*)(lds + GD_UP + (s * 16 + i) * 40 + c * 2) = bf1(t[i] * bc); *(LAS unsigned short*)(lds + GD_TB + (s * 16 + i) * 40 + c * 2) = bf1(t[i] * bge); }
        }
        __syncthreads();
#pragma unroll
        for (int jj = 0; jj < 2; ++jj) {
            const int job = wave * 2 + jj, s = job >> 3, dt = job & 7;
            const s4v a = *(const LAS s4v*)(lds + GD_TB + (s * 16 + r15) * 40 + 4 * g * 2);
            const s4v b = *(const LAS s4v*)(lds + GD_KT0 + (16 * dt + r15) * 72 + (16 * s + 4 * g) * 2);
            const v4f d = __builtin_amdgcn_mfma_f32_16x16x16bf16_1k(a, b, (v4f){0.f, 0.f, 0.f, 0.f}, 0, 0, 0);
#pragma unroll
            for (int r = 0; r < 4; ++r) *(LAS unsigned short*)(lds + GD_NW + (16 * s + 4 * g + r) * 272 + (16 * dt + r15) * 2) = bf1(-d[r]);
        }
        __syncthreads();
#pragma unroll
        for (int s = 0; s < 2; ++s) {
            const int jb = 16 * s;
            mfma_fence8(acc);
            const s4v vb = *(const LAS s4v*)(lds + GD_VT + (16 * wave + r15) * 72 + (jb + 4 * g) * 2);
            v4f vn = __builtin_amdgcn_mfma_f32_16x16x16bf16_1k(*(const LAS s4v*)(lds + GD_UP + (s * 16 + r15) * 40 + 4 * g * 2), vb, (v4f){0.f, 0.f, 0.f, 0.f}, 0, 0, 0);
            s8v sb[4];
#pragma unroll
            for (int kp = 0; kp < 4; ++kp) { const int off = (jb + r15) * 272 + (32 * kp + 4 * g) * 2;
                sb[kp] = cat8(cvt4(acc[2 * kp]), cvt4(acc[2 * kp + 1]));
                vn = __builtin_amdgcn_mfma_f32_16x16x32_bf16(cat8(*(const LAS s4v*)(lds + GD_NW + off), *(const LAS s4v*)(lds + GD_NW + off + 32)), sb[kp], vn, 0, 0, 0); }
            mfma_fence(vn);
            const s4v vnb = cvt4(vn);
            v4f o = __builtin_amdgcn_mfma_f32_16x16x16bf16_1k(*(const LAS s4v*)(lds + GD_AT + (s * 16 + r15) * 40 + 4 * g * 2), vnb, (v4f){0.f, 0.f, 0.f, 0.f}, 0, 0, 0);
#pragma unroll
            for (int kp = 0; kp < 4; ++kp) { const int off = (jb + r15) * 272 + (32 * kp + 4 * g) * 2;
                o = __builtin_amdgcn_mfma_f32_16x16x32_bf16(cat8(*(const LAS s4v*)(lds + GD_GQ + off), *(const LAS s4v*)(lds + GD_GQ + off + 32)), sb[kp], o, 0, 0, 0); }
#pragma unroll
            for (int r = 0; r < 4; ++r) { const int st = b0 + jb + 4 * g + r, pos = dir ? L - 1 - st : st; OBc[(size_t)(tok0 + pos) * DM] = o[r]; }
            const float gcs = *(const LAS float*)(lds + GD_GC + s * 4);
#pragma unroll
            for (int dt = 0; dt < 8; ++dt) { const s4v ka = *(const LAS s4v*)(lds + GD_KBT + (16 * dt + r15) * 72 + (jb + 4 * g) * 2);
                acc[dt] = __builtin_amdgcn_mfma_f32_16x16x16bf16_1k(ka, vnb, acc[dt] * gcs, 0, 0, 0); }
        }
    }
    if (!samp) { int seq2 = seq; asm volatile("" : "+s"(seq2));
        float* so = p.out + O_GDN + ((((size_t)seq2 * 2 + l) * 2 + dir) * 4 + hh) * 16384 + 16 * wave + r15;
#pragma unroll
        for (int dt = 0; dt < 8; ++dt)
#pragma unroll
            for (int r = 0; r < 4; ++r) so[(16 * dt + 4 * g + r) * 128] = acc[dt][r]; }
}

DEV void gdn_load_raw(const bf16_t* PROJ, int tok0, int L, int dir, int b0, int ti, int ch, v4u (&rw)[9]) {
    const int st = b0 + ti, pos = dir ? L - 1 - st : st;
    const bf16_t* row = PROJ + (size_t)(tok0 + pos) * PW + 4 * 512 + ch;
    const bool hm = pos > 0, hp = pos + 1 < L;
#pragma unroll
    for (int part = 0; part < 3; ++part) { const bf16_t* src = row + part * 512;
        rw[part * 3 + 0] = hm ? *(const v4u*)(src - PW) : (v4u){0u, 0u, 0u, 0u};
        rw[part * 3 + 1] = *(const v4u*)src;
        rw[part * 3 + 2] = hp ? *(const v4u*)(src + PW) : (v4u){0u, 0u, 0u, 0u}; }
}
DEV void gdn_half_task(const Params& p, int l, int seq, int hh, int dir, int eh, LAS float* lds, const int wave) {
    const int lane = lane_id_(), tid = wave * 64 + lane, dg = lane & 7, eg = lane >> 3;
    const int L = seq_len(seq), tok0 = seq_tok0(seq); const bool samp = seq >= 16;
    const int e0 = eh * 64 + wave * 8 + eg, d0 = dg * 16, d0p = d0 + 4 * (d0 >> 6);
    unsigned char* ws = p.ws;
    const bf16_t* PROJ = (const bf16_t*)(ws + WS_PROJ);
    float* OB = (float*)(ws + WS_OBUF) + (size_t)dir * T_TOK * DM + 512 + hh * 128 + e0;
    constexpr int RS = 136;
    LAS float* qs = lds; LAS float* ks = lds + NB * RS; LAS float* vs = lds + 2 * NB * RS; LAS float* scl = vs + NB * 128; LAS float* cwl = scl + NB * 4;
    v2f S[8];
    if (samp) { const float* st = p.in[I_SGDN] + ((((size_t)(seq - 16) * 2 + l) * 2 + dir) * 4 + hh) * 16384 + e0;
#pragma unroll
        for (int m = 0; m < 8; ++m) S[m] = (v2f){st[(d0 + 2 * m) * 128], st[(d0 + 2 * m + 1) * 128]};
    } else {
#pragma unroll
        for (int m = 0; m < 8; ++m) S[m] = (v2f){0.f, 0.f};
    }
    const int ti = tid >> 4, sub = tid & 15, c0 = sub * 8, ch = hh * 128 + c0;
    if (tid < 288) { const int pk = tid >> 5, part = pk / 3, kk = pk % 3, c4 = (tid & 31) * 4;
        *(LAS v4f*)(cwl + pk * 128 + c4) = *(const v4f*)(p.in[I_GCONV] + (size_t)l * 3 * 1536 + kk * 1536 + part * 512 + hh * 128 + c4); }
    v4u raw[9];
    gdn_load_raw(PROJ, tok0, L, dir, 0, ti, ch, raw);
    for (int b0 = 0; b0 < L; b0 += NB) {
        __syncthreads();
        {
            const int st = b0 + ti, pos = dir ? L - 1 - st : st, tok = tok0 + pos;
            float q[8], k[8], v[8];
#pragma unroll
            for (int part = 0; part < 3; ++part) {
                float xm[8], x0[8], xp[8];
                unpack8(raw[part * 3 + 0], xm); unpack8(raw[part * 3 + 1], x0); unpack8(raw[part * 3 + 2], xp);
                const LAS float* w = cwl + part * 384 + c0;
                const v4f w0a = *(const LAS v4f*)w, w0b = *(const LAS v4f*)(w + 4), w1a = *(const LAS v4f*)(w + 128), w1b = *(const LAS v4f*)(w + 132), w2a = *(const LAS v4f*)(w + 256), w2b = *(const LAS v4f*)(w + 260);
                const float w0[8] = {w0a.x, w0a.y, w0a.z, w0a.w, w0b.x, w0b.y, w0b.z, w0b.w}, w1[8] = {w1a.x, w1a.y, w1a.z, w1a.w, w1b.x, w1b.y, w1b.z, w1b.w},
                            w2[8] = {w2a.x, w2a.y, w2a.z, w2a.w, w2b.x, w2b.y, w2b.z, w2b.w};
#pragma unroll
                for (int i = 0; i < 8; ++i) { const float y = xm[i] * w0[i] + x0[i] * w1[i] + xp[i] * w2[i]; const float sv = siluf_(y);
                    if (part == 0) q[i] = sv; else if (part == 1) k[i] = sv; else v[i] = sv; }
            }
            float sq = 0.f, sk = 0.f;
#pragma unroll
            for (int i = 0; i < 8; ++i) { sq += q[i] * q[i]; sk += k[i] * k[i]; }
            sq = row16_sum(sq); sk = row16_sum(sk);
            const float rq = rsqrtf(sq + EPSN) * HD_SCALE, rk = rsqrtf(sk + EPSN);
            float kq = 0.f;
#pragma unroll
            for (int i = 0; i < 8; ++i) { q[i] *= rq; k[i] *= rk; kq += q[i] * k[i]; }
            kq = row16_sum(kq);
            if (sub == 0) {
                const float* AB = (const float*)(ws + WS_AB) + (size_t)tok * 16;
                const float ap = AB[dir * 4 + hh] + p.in[I_GDTB][(l * 2 + dir) * 4 + hh], bp = AB[8 + dir * 4 + hh];
                const float sp = fmaxf(ap, 0.f) + log1pf(expf(-fabsf(ap)));
                const float alpha = expf(-expf(p.in[I_GALOG][(l * 2 + dir) * 4 + hh]) * sp);
                *(LAS v4f*)(scl + ti * 4) = (v4f){alpha, sigmoidf_(bp), kq, 0.f};
            }
            const int c0p = c0 + 4 * (c0 >> 6);
            *(LAS v4f*)(qs + ti * RS + c0p) = (v4f){q[0], q[1], q[2], q[3]}; *(LAS v4f*)(qs + ti * RS + c0p + 4) = (v4f){q[4], q[5], q[6], q[7]};
            *(LAS v4f*)(ks + ti * RS + c0p) = (v4f){k[0], k[1], k[2], k[3]}; *(LAS v4f*)(ks + ti * RS + c0p + 4) = (v4f){k[4], k[5], k[6], k[7]};
            *(LAS v4f*)(vs + ti * 128 + c0) = (v4f){v[0], v[1], v[2], v[3]}; *(LAS v4f*)(vs + ti * 128 + c0 + 4) = (v4f){v[4], v[5], v[6], v[7]};
        }
        if (b0 + NB < L) gdn_load_raw(PROJ, tok0, L, dir, b0 + NB, ti, ch, raw);
        __syncthreads();
#pragma unroll 4
        for (int i = 0; i < NB; ++i) {
            const LAS v4f* kp = (const LAS v4f*)(ks + i * RS + d0p); const LAS v4f* qp = (const LAS v4f*)(qs + i * RS + d0p);
            const v4f k0 = kp[0], k1 = kp[1], k2 = kp[2], k3 = kp[3], q0 = qp[0], q1 = qp[1], q2 = qp[2], q3 = qp[3];
            const float vv = vs[i * 128 + e0];
            const v2f kk[8] = {{k0.x, k0.y}, {k0.z, k0.w}, {k1.x, k1.y}, {k1.z, k1.w}, {k2.x, k2.y}, {k2.z, k2.w}, {k3.x, k3.y}, {k3.z, k3.w}};
            const v2f qq[8] = {{q0.x, q0.y}, {q0.z, q0.w}, {q1.x, q1.y}, {q1.z, q1.w}, {q2.x, q2.y}, {q2.z, q2.w}, {q3.x, q3.y}, {q3.z, q3.w}};
            const v4f sc4 = *(const LAS v4f*)(scl + i * 4);
            v2f r2 = (v2f){0.f, 0.f}, o2 = (v2f){0.f, 0.f};
#pragma unroll
            for (int m = 0; m < 8; ++m) { S[m] = S[m] * sc4.x; r2 += S[m] * kk[m]; o2 += S[m] * qq[m]; }
            float r = r2.x + r2.y, o = o2.x + o2.y;
            r += dppf<0xB1>(r); r += dppf<0x4E>(r); r += dppf<0x141>(r);
            const float vn = (vv - r) * sc4.y;
#pragma unroll
            for (int m = 0; m < 8; ++m) S[m] += kk[m] * vn;
            o += dppf<0xB1>(o); o += dppf<0x4E>(o); o += dppf<0x141>(o);
            o += vn * sc4.z;
            if (dg == 0) { const int st = b0 + i, pos = dir ? L - 1 - st : st; OB[(size_t)(tok0 + pos) * DM] = o; }
        }
    }
    if (!samp) { float* so = p.out + O_GDN + ((((size_t)seq * 2 + l) * 2 + dir) * 4 + hh) * 16384 + e0;
#pragma unroll
        for (int m = 0; m < 8; ++m) { so[(d0 + 2 * m) * 128] = S[m].x; so[(d0 + 2 * m + 1) * 128] = S[m].y; } }
}

DEV void s5_task(const Params& p, int l, int seq, int g, int dir, LAS float* wl) {
    const int lane = lane_id_();
    const int L = seq_len(seq), tok0 = seq_tok0(seq); const bool samp = seq >= 16;
    unsigned char* ws = p.ws;
    const bf16_t* PROJ = (const bf16_t*)(ws + WS_PROJ) + 13 * 512 + g * 16;
    float* OB = (float*)(ws + WS_OBUF) + (size_t)dir * T_TOK * DM + 1536 + g * 16;
    LAS float* xs = wl; LAS float* us = wl + 16 * 132;
    const int cg_ = (l * 2 + dir) * 32 + g, idx = cg_ * 64 + lane;
    const float ar = ((const float*)(ws + WS_S5A))[idx], ai = ((const float*)(ws + WS_S5A))[8192 + idx];
    v2f bb[16];
    { const float* BR = (const float*)(ws + WS_S5B) + (size_t)idx * 16; const float* BI = BR + 131072;
#pragma unroll
        for (int c4 = 0; c4 < 4; ++c4) { const v4f a = *(const v4f*)(BR + c4 * 4), b = *(const v4f*)(BI + c4 * 4);
            bb[c4 * 4] = (v2f){a.x, b.x}; bb[c4 * 4 + 1] = (v2f){a.y, b.y}; bb[c4 * 4 + 2] = (v2f){a.z, b.z}; bb[c4 * 4 + 3] = (v2f){a.w, b.w}; } }
    float Areg[32];
    { const float* CR = p.in[I_SCRE] + (size_t)cg_ * 1024 + (lane & 15) * 64; const float* CI = p.in[I_SCIM] + (size_t)cg_ * 1024 + (lane & 15) * 64;
#pragma unroll
        for (int ks = 0; ks < 32; ++ks) { const int k = 4 * ks + (lane >> 4); Areg[ks] = ks < 16 ? CR[k] : -CI[k - 64]; } }
    float xr = 0.f, xi = 0.f;
    if (samp) { const size_t si = ((((size_t)(seq - 16) * 2 + l) * 2 + dir) * 32 + g) * 64 + lane; xr = p.in[I_S5RE][si]; xi = p.in[I_S5IM][si]; }
    v2u wn; { const int st = (lane >> 2), pos = dir ? L - 1 - st : st; wn = *(const v2u*)(PROJ + (size_t)(tok0 + pos) * PW + (lane & 3) * 4); }
    for (int blk = 0; blk < L; blk += 16) {
        { const v2u w = wn;
          if (blk + 16 < L) { const int st = blk + 16 + (lane >> 2), pos = dir ? L - 1 - st : st; wn = *(const v2u*)(PROJ + (size_t)(tok0 + pos) * PW + (lane & 3) * 4); }
          *(LAS v4f*)(us + (lane >> 2) * 16 + (lane & 3) * 4) = (v4f){lo_bf(w.x), hi_bf(w.x), lo_bf(w.y), hi_bf(w.y)}; }
        LDS_WAIT();
#pragma unroll 4
        for (int t = 0; t < 16; ++t) {
            v2f bu0 = (v2f){0.f, 0.f}, bu1 = (v2f){0.f, 0.f};
#pragma unroll
            for (int c4 = 0; c4 < 4; ++c4) { const v4f u = *(const LAS v4f*)(us + t * 16 + c4 * 4);
                bu0 += bb[c4 * 4] * u.x; bu1 += bb[c4 * 4 + 1] * u.y; bu0 += bb[c4 * 4 + 2] * u.z; bu1 += bb[c4 * 4 + 3] * u.w; }
            const v2f bu = bu0 + bu1;
            const float nr = ar * xr - ai * xi + bu.x, ni = ar * xi + ai * xr + bu.y; xr = nr; xi = ni;
            xs[t * 132 + lane] = xr; xs[t * 132 + 64 + lane] = xi;
        }
        LDS_WAIT();
        v4f a0 = (v4f){0.f, 0.f, 0.f, 0.f}, a1 = (v4f){0.f, 0.f, 0.f, 0.f};
#pragma unroll
        for (int ks = 0; ks < 32; ks += 2) {
            const float b0 = xs[(lane & 15) * 132 + 4 * ks + (lane >> 4)], b1 = xs[(lane & 15) * 132 + 4 * ks + 4 + (lane >> 4)];
            a0 = __builtin_amdgcn_mfma_f32_16x16x4f32(Areg[ks], b0, a0, 0, 0, 0);
            a1 = __builtin_amdgcn_mfma_f32_16x16x4f32(Areg[ks + 1], b1, a1, 0, 0, 0);
        }
        { const int st = blk + (lane & 15), pos = dir ? L - 1 - st : st; *(v4f*)(OB + (size_t)(tok0 + pos) * DM + (lane >> 4) * 4) = a0 + a1; }
        LDS_WAIT();
    }
    if (!samp) { const size_t so = ((((size_t)seq * 2 + l) * 2 + dir) * 32 + g) * 64 + lane; p.out[O_S5RE + so] = xr; p.out[O_S5IM + so] = xi; }
}

DEV void mixer_phase(const Params& p, int l, LAS unsigned char* lds, const int wave, const int rep = 0) {
    const int tid = wave * 64 + lane_id_();
    unsigned* ctr = (unsigned*)(p.ws + WS_CTL) + 64 * (l + 2 * rep);
    volatile LAS unsigned* slot = (volatile LAS unsigned*)(lds + LDS_BYTES - 64);
    for (;;) {
        __syncthreads();
        if (tid == 0) *slot = atomicAdd(ctr, 1u);
        __syncthreads();
        const int t = (int)*slot;
        if (t >= 960) break;
        int mt, seq, rem, eh = 0;
        if (t < 128) { mt = 1; rem = t >> 1; eh = t & 1; seq = 16 + (rem >> 3); }
        else if (t < 192) { mt = 3; rem = t - 128; seq = 16 + (rem >> 3); }
        else if (t < 448) { const int j = t - 192; mt = 1; rem = j >> 1; eh = j & 1; seq = rem >> 3; }
        else if (t < 576) { const int j = t - 448; mt = (j >> 6) ? 2 : 0; rem = j & 63; seq = 16 + (rem >> 3); }
        else if (t < 704) { mt = 3; rem = t - 576; seq = rem >> 3; }
        else { const int j = t - 704; mt = (j >> 7) ? 2 : 0; rem = j & 127; seq = rem >> 3; }
        const int hh = (rem >> 1) & 3, dir = rem & 1;
        if (mt == 0) gla_task<0>(p, l, seq, hh, dir, lds, wave);
        else if (mt == 1) gdn_half_task(p, l, seq, hh, dir, eh, (LAS float*)lds, wave);
        else if (mt == 2) gla_task<2>(p, l, seq, hh, dir, lds, wave);
        else s5_task(p, l, seq, (rem & 7) * 4 + (wave >> 1), wave & 1, (LAS float*)(lds + wave * 9472));
    }
}

DEV void post_phase(const Params& p, int l, const int wave) {
    const int lane = lane_id_();
    const int gw = blockIdx.x * NWAVES + wave, NGW = gridDim.x * NWAVES;
    unsigned char* ws = p.ws;
    const float* O0 = (const float*)(ws + WS_OBUF); const float* O1 = O0 + (size_t)T_TOK * DM;
    const int hc = (lane & 15) * 8;
    for (int row = gw; row < T_TOK; row += NGW) {
        const bf16_t* pr = (const bf16_t*)(ws + WS_PROJ) + (size_t)row * PW;
        bf16_t* mix = (bf16_t*)(ws + WS_HB) + (size_t)row * DM;
#pragma unroll
        for (int seg = 0; seg < 4; ++seg) {
            const int col = seg * 512 + lane * 8;
            const v4f a0 = __builtin_nontemporal_load((const v4f*)(O0 + (size_t)row * DM + col)), a1 = __builtin_nontemporal_load((const v4f*)(O0 + (size_t)row * DM + col + 4));
            const v4f b0 = __builtin_nontemporal_load((const v4f*)(O1 + (size_t)row * DM + col)), b1 = __builtin_nontemporal_load((const v4f*)(O1 + (size_t)row * DM + col + 4));
            float a[8] = {a0.x + b0.x, a0.y + b0.y, a0.z + b0.z, a0.w + b0.w, a1.x + b1.x, a1.y + b1.y, a1.z + b1.z, a1.w + b1.w};
            float o[8];
            if (seg < 3) {
                float g[8]; unpack8(*(const v4u*)(pr + (seg == 0 ? 3 : (seg == 1 ? 7 : 12)) * 512 + lane * 8), g);
                if (seg == 0) {
                    float s = 0.f;
#pragma unroll
                    for (int i = 0; i < 8; ++i) s += a[i];
                    const float mean = row16_sum(s) * (1.0f / 128.0f); float q = 0.f;
#pragma unroll
                    for (int i = 0; i < 8; ++i) { a[i] -= mean; q += a[i] * a[i]; }
                    const float rs = rsqrtf(row16_sum(q) * (1.0f / 128.0f) + EPSN);
#pragma unroll
                    for (int i = 0; i < 8; ++i) o[i] = a[i] * rs * siluf_(g[i]);
                } else {
                    const float* nw = p.in[seg == 1 ? I_GNW : I_HNW] + l * 128 + hc; float q = 0.f;
#pragma unroll
                    for (int i = 0; i < 8; ++i) q += a[i] * a[i];
                    const float rs = rsqrtf(row16_sum(q) * (1.0f / 128.0f) + EPSN);
#pragma unroll
                    for (int i = 0; i < 8; ++i) o[i] = a[i] * rs * nw[i] * siluf_(g[i]);
                }
                *(v4u*)(mix + col) = pack8(o);
            } else {
                float su[8]; unpack8(*(const v4u*)(pr + 13 * 512 + lane * 8), su);
                const float* dd = p.in[I_S5D] + l * 512 + lane * 8;
#pragma unroll
                for (int i = 0; i < 8; ++i) { const float y = a[i] + dd[i] * su[i]; const float u = 0.7978845608028654f * (y + 0.044715f * y * y * y);
                    o[i] = 0.5f * y * (1.0f + tanhf(u)); }
                *(v4u*)((bf16_t*)(ws + WS_Z) + (size_t)row * 512 + lane * 8) = pack8(o);
            }
        }
    }
}

#define PH_IN(k) (lo <= (k) && (k) < hi)
DEV void grid_bar(unsigned* ctr, unsigned target, const int wave) {
    asm volatile("s_waitcnt vmcnt(0) lgkmcnt(0)" ::: "memory");
    __syncthreads();
    if (wave == 0 && lane_id_() == 0) {
        __hip_atomic_fetch_add(ctr, 1u, __ATOMIC_RELEASE, __HIP_MEMORY_SCOPE_AGENT);
        while (__hip_atomic_load(ctr, __ATOMIC_RELAXED, __HIP_MEMORY_SCOPE_AGENT) < target) __builtin_amdgcn_s_sleep(2);
        __builtin_amdgcn_fence(__ATOMIC_ACQUIRE, "agent");
        asm volatile("s_waitcnt vmcnt(0)" ::: "memory");
    }
    __syncthreads();
}
#define PH_SEAM(k) do { if (PH_IN(k) && PH_IN((k) + 1)) { if ((k) == 0) grid.sync(); else grid_bar((unsigned*)(p.ws + WS_CTL) + 256, (unsigned)(k) * gridDim.x, wave); } } while (0)
template <int L_> DEV void layer_phases(const Params& p, LAS unsigned char* lds, cg::grid_group& grid, int lo, int hi, const int wave) {
    constexpr int l = L_, B = 1 + 9 * L_;
    unsigned char* ws = p.ws;
    const float* mod = (const float*)(ws + WS_MOD) + (size_t)l * 9 * NMOD;
    if (PH_IN(B + 0)) norm_phase<0>(p, l, wave);
    PH_SEAM(B + 0);
    if (PH_IN(B + 1)) {
        pg8::Gemm g{(const bf16_t*)(ws + WS_HB), (const bf16_t*)(ws + WS_WIN) + (size_t)l * PW * DM, T_TOK, PW, DM}; pg8::StaticOrder S; S.init(T_TOK, PW, gridDim.x, blockIdx.x);
        EpiProjBf16 E{(bf16_t*)(ws + WS_PROJ), PW};
        pg8::gemm_phase<EpiProjBf16, pg8::StaticOrder>(lds, g, S, E, nullptr, wave);
    }
    PH_SEAM(B + 1);
    if (PH_IN(B + 2)) mixer_phase(p, l, lds, wave);
#ifdef PROBE_MIXER2
    if (PH_IN(B + 2)) mixer_phase(p, l, lds, wave, 1);
#endif
    PH_SEAM(B + 2);
    if (PH_IN(B + 3)) post_phase(p, l, wave);
    PH_SEAM(B + 3);
    if (PH_IN(B + 4)) {
        pg8::Gemm g{(const bf16_t*)(ws + WS_Z), (const bf16_t*)(ws + WS_WGLU) + (size_t)l * 512 * 512, T_TOK, 512, 512}; pg8::StaticOrder S; S.init(T_TOK, 512, gridDim.x, blockIdx.x);
        EpiGlu E{(const bf16_t*)(ws + WS_Z), (bf16_t*)(ws + WS_HB), p.in[I_GLUB] + l * 512};
        pg8::gemm_phase<EpiGlu, pg8::StaticOrder>(lds, g, S, E, nullptr, wave);
    }
    PH_SEAM(B + 4);
    if (PH_IN(B + 5)) {
        pg8::Gemm g{(const bf16_t*)(ws + WS_HB), (const bf16_t*)(ws + WS_WOUT) + (size_t)l * DM * DM, T_TOK, DM, DM}; pg8::StaticOrder S; S.init(T_TOK, DM, gridDim.x, blockIdx.x);
        float* xr = (float*)(ws + WS_XRES);
        EpiResid E{l == 0 ? p.in[I_XP] : xr, l == 0 ? p.in[I_XS] : xr, l == 0 ? NTP : 0, xr, mod + 2 * DM};
        pg8::gemm_phase<EpiResid, pg8::StaticOrder>(lds, g, S, E, nullptr, wave);
    }
    PH_SEAM(B + 5);
    if (PH_IN(B + 6)) norm_phase<1>(p, l, wave);
    PH_SEAM(B + 6);
    if (PH_IN(B + 7)) {
        pg8::Gemm g{(const bf16_t*)(ws + WS_HB), (const bf16_t*)(ws + WS_W13) + (size_t)l * 2 * FFH * DM, T_TOK, 2 * FFH, DM}; pg8::StaticOrder S; S.init(T_TOK, 2 * FFH, gridDim.x, blockIdx.x);
        EpiGated E{(bf16_t*)(ws + WS_PROJ)};
        pg8::gemm_phase<EpiGated, pg8::StaticOrder>(lds, g, S, E, nullptr, wave);
    }
    PH_SEAM(B + 7);
    if (PH_IN(B + 8)) {
        pg8::Gemm g{(const bf16_t*)(ws + WS_PROJ), (const bf16_t*)(ws + WS_W2) + (size_t)l * DM * FFH, T_TOK, DM, FFH}; pg8::StaticOrder S; S.init(T_TOK, DM, gridDim.x, blockIdx.x);
        float* xr = (float*)(ws + WS_XRES);
        EpiResid E{xr, xr, 0, xr, mod + 5 * DM};
        pg8::gemm_phase<EpiResid, pg8::StaticOrder>(lds, g, S, E, nullptr, wave);
    }
    PH_SEAM(B + 8);
}
__global__ void __launch_bounds__(NTHREADS, 2) trunk_fwd(Params p) {
    extern __shared__ __attribute__((aligned(16))) unsigned char lds_raw[];
    LAS unsigned char* lds = (LAS unsigned char*)lds_raw;
    cg::grid_group grid = cg::this_grid();
    const int lo = p.ph_lo, hi = p.ph_hi;
    const int wave = __builtin_amdgcn_readfirstlane((int)(threadIdx.x >> 6));
    if (PH_IN(0)) phase0(p, lds, wave);
    PH_SEAM(0);
    layer_phases<0>(p, lds, grid, lo, hi, wave);
    layer_phases<1>(p, lds, grid, lo, hi, wave);
    if (PH_IN(19)) norm_phase<2>(p, 0, wave);
}

#ifndef N_LAUNCH_MODE
#define N_LAUNCH_MODE 1
#endif
extern "C" void kernel_launch(void* const* d_in, const int* in_sizes, int n_in, void* d_out, int out_size, void* d_ws, size_t ws_size, hipStream_t stream) {
    static int grid = 0;
    if (grid == 0) {
        if (n_in != 36 || ws_size < WS_END) { fprintf(stderr, "kernel_launch: expected 36 inputs and >= %zu bytes of workspace, got %d / %zu\n", (size_t)WS_END, n_in, ws_size); grid = -1; return; }
        int dev = 0, cus = 0, per_cu = 0;
        hipGetDevice(&dev); hipDeviceGetAttribute(&cus, hipDeviceAttributeMultiprocessorCount, dev);
        if (hipFuncSetAttribute((const void*)trunk_fwd, hipFuncAttributeMaxDynamicSharedMemorySize, LDS_BYTES) != hipSuccess) { fprintf(stderr, "kernel_launch: hipFuncSetAttribute failed\n"); grid = -1; return; }
        hipOccupancyMaxActiveBlocksPerMultiprocessor(&per_cu, (const void*)trunk_fwd, NTHREADS, LDS_BYTES);
        if (per_cu < 1) { fprintf(stderr, "kernel_launch: occupancy query says %d blocks per CU\n", per_cu); per_cu = 1; }
        (void)hipGetLastError();
        grid = cus;
    }
    if (grid < 0) return;
    hipMemsetAsync((char*)d_ws + WS_CTL, 0, 4096, stream);
    Params p{};
    for (int i = 0; i < 36; ++i) p.in[i] = (const float*)d_in[i];
    p.out = (float*)d_out; p.ws = (unsigned char*)d_ws;
#if N_LAUNCH_MODE == 1
    p.ph_lo = 0; p.ph_hi = 20;
    void* args[] = {&p};
    hipError_t e = hipLaunchCooperativeKernel((const void*)trunk_fwd, dim3(grid), dim3(NTHREADS), args, LDS_BYTES, stream);
    if (e != hipSuccess) fprintf(stderr, "cooperative launch failed: %s (grid %d)\n", hipGetErrorString(e), grid);
#else
    for (int ph = 0; ph < 20; ++ph) { p.ph_lo = ph; p.ph_hi = ph + 1; hipLaunchKernelGGL(trunk_fwd, dim3(grid), dim3(NTHREADS), LDS_BYTES, stream, p); }
#endif
}
```
